# Optimizing an MI355X kernel written in HIP

```python
import jax, jax.numpy as jnp
from jax import lax
import numpy as np

D_MODEL = 2048
BATCH = 4
SEQ = 4096
DEPTH = 1

A_HEAD_DIM = 128
A_WIDTH = D_MODEL // 2
A_HEADS = A_WIDTH // A_HEAD_DIM
A_CHUNK = 64
B_HEAD_DIM = 64
B_WIDTH = D_MODEL // 2
B_Q_HEADS = B_WIDTH // B_HEAD_DIM
B_GROUP = 4
B_KV_HEADS = B_Q_HEADS // B_GROUP
B_KV_WIDTH = B_KV_HEADS * B_HEAD_DIM
WINDOW = 128
BLOCK = 128
MLP_HIDDEN = 4 * D_MODEL
N_MOD = 6
EPS = 1e-6

SPLIT_SIZES = (A_WIDTH, A_WIDTH, A_WIDTH, A_WIDTH,
               B_WIDTH, B_KV_WIDTH, B_KV_WIDTH,
               D_MODEL, D_MODEL)
IN_WIDTH = 4 * A_WIDTH + B_WIDTH + 2 * B_KV_WIDTH + 2 * D_MODEL

kernel_name = "hybrid_hgrn2_swa_sink_gated_block"


def split_columns(t):
    idx, acc = [], 0
    for s in SPLIT_SIZES[:-1]:
        acc += s
        idx.append(acc)
    return jnp.split(t, idx, axis=-1)


def rms_norm(x, gain):
    xf = x.astype(jnp.float32)
    y = xf * lax.rsqrt(jnp.mean(xf * xf, axis=-1, keepdims=True) + EPS)
    return (y * gain.astype(jnp.float32)).astype(x.dtype)


def head_rms(t, gain):
    return t * lax.rsqrt(jnp.mean(t * t, axis=-1, keepdims=True) + EPS) * gain.astype(jnp.float32)


def hgrn2_mixer(q, f_logit, i, g, lb, o_gain):
    f32 = jnp.float32
    bsz, seq, _ = q.shape
    H, K, C = A_HEADS, A_HEAD_DIM, A_CHUNK
    n = seq // C
    lbf = lb.astype(f32)
    f = lbf + (1.0 - lbf) * jax.nn.sigmoid(f_logit.astype(f32))
    log_f = jnp.log(f)
    k = 1.0 - f
    qf = jax.nn.silu(q.astype(f32))

    def to_chunks(t):
        return t.reshape(bsz, n, C, H, K).transpose(0, 3, 1, 2, 4)

    qc, kc, vc, lfc = (to_chunks(t) for t in (qf, k, i.astype(f32), log_f))
    b = jnp.cumsum(lfc, axis=3)
    b_mid = b[:, :, :, C // 2 - 1:C // 2, :]
    b_last = b[:, :, :, C - 1:C, :]
    q_dec = qc * jnp.exp(b - b_mid)
    k_dec = kc * jnp.exp(b_mid - b)
    causal = jnp.tril(jnp.ones((C, C), dtype=bool))
    scores = jnp.where(causal, jnp.einsum('bhntk,bhnsk->bhnts', q_dec, k_dec), 0.0)
    o_intra = jnp.einsum('bhnts,bhnsv->bhntv', scores, vc)
    d_state = jnp.einsum('bhnsk,bhnsv->bhnkv', kc * jnp.exp(b_last - b), vc)
    chunk_decay = jnp.exp(b_last[:, :, :, 0, :])

    def step(state, inp):
        ds, dec = inp
        return dec[..., None] * state + ds, state

    s0 = jnp.zeros((bsz, H, K, K), f32)
    _, s_prev = lax.scan(step, s0, (jnp.moveaxis(d_state, 2, 0), jnp.moveaxis(chunk_decay, 2, 0)))
    s_prev = jnp.moveaxis(s_prev, 0, 2)
    o_inter = jnp.einsum('bhntk,bhnkv->bhntv', qc * jnp.exp(b), s_prev)
    o = (o_intra + o_inter).transpose(0, 2, 3, 1, 4).reshape(bsz, seq, H, K)
    o = head_rms(o, o_gain.reshape(H, K)).reshape(bsz, seq, A_WIDTH)
    o = o * jax.nn.silu(g.astype(f32))
    return o.astype(q.dtype)


def swa_sink_attention(q, k, v, q_gain, k_gain, sinks):
    f32 = jnp.float32
    bsz, seq, _ = q.shape
    nb = seq // BLOCK
    qh = head_rms(q.astype(f32).reshape(bsz, seq, B_KV_HEADS, B_GROUP, B_HEAD_DIM), q_gain)
    kh = head_rms(k.astype(f32).reshape(bsz, seq, B_KV_HEADS, B_HEAD_DIM), k_gain)
    vh = v.astype(f32).reshape(bsz, seq, B_KV_HEADS, B_HEAD_DIM)
    qb = qh.reshape(bsz, nb, BLOCK, B_KV_HEADS, B_GROUP, B_HEAD_DIM)
    kb = kh.reshape(bsz, nb, BLOCK, B_KV_HEADS, B_HEAD_DIM)
    vb = vh.reshape(bsz, nb, BLOCK, B_KV_HEADS, B_HEAD_DIM)

    def with_prev(t):
        prev = jnp.concatenate([jnp.zeros_like(t[:, :1]), t[:, :-1]], axis=1)
        return jnp.concatenate([prev, t], axis=2)

    kw, vw = with_prev(kb), with_prev(vb)
    scale = B_HEAD_DIM ** -0.5
    scores = jnp.einsum('bnqhgd,bnkhd->bnhgqk', qb, kw) * scale
    qi = jnp.arange(BLOCK)[:, None] + BLOCK
    ki = jnp.arange(2 * BLOCK)[None, :]
    rel = qi - ki
    band = (rel >= 0) & (rel < WINDOW)
    has_key = (jnp.arange(nb) > 0)[:, None, None] | (ki >= BLOCK)[None]
    mask = band[None] & has_key
    scores = jnp.where(mask[None, :, None, None], scores, -jnp.inf)
    sink = jnp.broadcast_to(sinks.astype(f32).reshape(B_KV_HEADS, B_GROUP)[None, None, :, :, None, None],
                            scores.shape[:-1] + (1,))
    probs = jax.nn.softmax(jnp.concatenate([scores, sink], axis=-1), axis=-1)[..., :-1]
    out = jnp.einsum('bnhgqk,bnkhd->bnqhgd', probs, vw)
    return out.reshape(bsz, seq, B_WIDTH).astype(q.dtype)


def setup_inputs(seed: int = 0) -> dict:
    key = jax.random.key(seed)
    ks = jax.random.split(key, 20)
    f32 = jnp.float32

    def w(k, shape, fan_in):
        return jax.random.normal(k, shape, f32) * (fan_in ** -0.5)

    return {
        "x": jax.random.normal(ks[0], (BATCH, SEQ, D_MODEL), f32),
        "c": jax.random.normal(ks[1], (BATCH, D_MODEL), f32),
        "w_ada": w(ks[2], (DEPTH, D_MODEL, N_MOD * D_MODEL), D_MODEL),
        "b_ada": 0.02 * jax.random.normal(ks[3], (DEPTH, N_MOD * D_MODEL), f32),
        "norm1_gain": 1.0 + 0.02 * jax.random.normal(ks[4], (DEPTH, D_MODEL), f32),
        "w_in": w(ks[5], (DEPTH, D_MODEL, IN_WIDTH), D_MODEL),
        "lb_logits": 0.5 * jax.random.normal(ks[6], (DEPTH + 1, A_WIDTH), f32),
        "hgrn_o_gain": 1.0 + 0.02 * jax.random.normal(ks[7], (DEPTH, A_WIDTH), f32),
        "q_norm_gain": 1.0 + 0.02 * jax.random.normal(ks[8], (DEPTH, B_HEAD_DIM), f32),
        "k_norm_gain": 1.0 + 0.02 * jax.random.normal(ks[9], (DEPTH, B_HEAD_DIM), f32),
        "sinks": 0.5 * jax.random.normal(ks[10], (DEPTH, B_Q_HEADS), f32),
        "w_branch_a": w(ks[11], (DEPTH, A_WIDTH, D_MODEL), A_WIDTH),
        "w_branch_b": w(ks[12], (DEPTH, B_WIDTH, D_MODEL), B_WIDTH),
        "w_out": w(ks[13], (DEPTH, D_MODEL, D_MODEL), D_MODEL),
        "norm2_gain": 1.0 + 0.02 * jax.random.normal(ks[14], (DEPTH, D_MODEL), f32),
        "w_mlp_in": w(ks[15], (DEPTH, D_MODEL, MLP_HIDDEN), D_MODEL),
        "w_mlp_out": w(ks[16], (DEPTH, MLP_HIDDEN, D_MODEL), MLP_HIDDEN),
    }


def reference(x, c, w_ada, b_ada, norm1_gain, w_in, lb_logits, hgrn_o_gain, q_norm_gain,
              k_norm_gain, sinks, w_branch_a, w_branch_b, w_out, norm2_gain, w_mlp_in, w_mlp_out):
    lb_all = jnp.cumsum(jax.nn.softmax(lb_logits.astype(jnp.float32), axis=0), axis=0)
    for l in range(DEPTH):
        mod = jax.nn.silu(c) @ w_ada[l] + b_ada[l]
        sh1, sc1, gt1, sh2, sc2, gt2 = (m[:, None, :] for m in jnp.split(mod, N_MOD, axis=-1))
        h = rms_norm(x, norm1_gain[l]) * (1.0 + sc1) + sh1
        qa, fa, ia, ga, qb, kb, vb, gate_a, gate_b = split_columns(h @ w_in[l])
        ya = hgrn2_mixer(qa, fa, ia, ga, lb_all[l], hgrn_o_gain[l]) @ w_branch_a[l]
        yb = swa_sink_attention(qb, kb, vb, q_norm_gain[l], k_norm_gain[l], sinks[l]) @ w_branch_b[l]
        merged = jax.nn.sigmoid(gate_a) * ya + jax.nn.sigmoid(gate_b) * yb
        x = x + gt1 * (merged @ w_out[l])
        h2 = rms_norm(x, norm2_gain[l]) * (1.0 + sc2) + sh2
        x = x + gt2 * (jnp.square(jax.nn.relu(h2 @ w_mlp_in[l])) @ w_mlp_out[l])
    return x
```

```cpp
#include <hip/hip_runtime.h>
#include <hip/hip_cooperative_groups.h>
#include <cstdio>
#include <cstdint>
namespace cg = cooperative_groups;
namespace pg8 {
#define PG8_LAS __attribute__((address_space(3)))
typedef unsigned short bf16_t;
typedef short bf16x8 __attribute__((ext_vector_type(8)));
typedef float f32x4 __attribute__((ext_vector_type(4)));
typedef unsigned u32x4 __attribute__((ext_vector_type(4)));
constexpr int BM = 256, BK = 64, HALF = 128, HTB = HALF * BK * 2  , STAGE_BYTES = 8 * HTB, NXCD = 8, WGM = 8;

__host__ __device__ __forceinline__ int lds_byte(int r, int c) { const int st = (r >> 4) * 2 + (c >> 5), rr = r & 15, cc = c & 31, ob = rr * 64 + cc * 2; return st * 1024 + (ob ^ (((ob >> 9) & 1) << 5)); }
__host__ __device__ __forceinline__ void stage_rc(int b, int& R, int& C) { const int st = b / 1024, sb = b % 1024, swz = sb ^ (((sb >> 9) & 1) << 5); R = (st >> 1) * 16 + swz / 64; C = (st & 1) * 32 + (swz % 64) / 2; }
__host__ __device__ __forceinline__ int perm32(int rho) { const int n = rho >> 4, i = rho & 15; return 8 * (i >> 2) + 4 * n + (i & 3); }

struct Unit { int pm, pn; };
struct Gemm { const bf16_t* A; const bf16_t* Bt; int M, N, K; };

struct StaticOrder {
    int nM, nN, nwg, G, c;
    __host__ __device__ void init(int M, int N, int G_, int c_) { nM = M / BM; nN = N / BM; nwg = nM * nN; G = G_; c = c_; }
    __host__ __device__ bool next(int i, Unit& u) const {
        const long L = (long)i * G + c; if (L >= nwg) return false;
        int wgid = (int)L; { const int q = nwg / NXCD, r = nwg % NXCD, xcd = wgid % NXCD, off = wgid / NXCD; wgid = (xcd < r ? xcd * (q + 1) : r * (q + 1) + (xcd - r) * q) + off; }
        const int nig = WGM * nN, gid = wgid / nig, fm = gid * WGM, gsz = (nM - fm) < WGM ? (nM - fm) : WGM;
        u.pm = fm + ((wgid % nig) % gsz); u.pn = (wgid % nig) / gsz; return true;
    }
    __device__ __forceinline__ void a_ready(const Unit&) const {}
    __device__ __forceinline__ void done(const Unit&) const {}
};

__device__ __forceinline__ unsigned cvt_pk_bf16(float lo, float hi) { unsigned r; asm volatile("v_cvt_pk_bf16_f32 %0, %1, %2" : "=v"(r) : "v"(lo), "v"(hi)); return r; }
typedef float f32x2 __attribute__((ext_vector_type(2)));
typedef unsigned u32x2 __attribute__((ext_vector_type(2)));
__device__ __forceinline__ float bf2f(unsigned short h) { return __uint_as_float((unsigned)h << 16); }
__device__ __forceinline__ float bflo(unsigned w) { return __uint_as_float(w << 16); }
__device__ __forceinline__ float bfhi(unsigned w) { return __uint_as_float(w & 0xffff0000u); }

constexpr int PLD = 8704;
struct EpiIn {
    static constexpr bool PERM = true, AFTER_DRAIN = false;
    bf16_t* P; float* LOGF; const float* lbl;
    __device__ __forceinline__ void operator()(const f32x4 (&acc)[2][2][4][2], const Unit& u, int wr, int wc, int fr, int fq) const {
        const int pn = u.pn, row0 = u.pm * BM + wr * 64 + fr, colt = pn * BM + wc * 32 + 8 * fq;
        if (pn >= 4 && pn < 8) {
            float lbv[2][8];
#pragma unroll
            for (int bj = 0; bj < 2; ++bj)
#pragma unroll
                for (int e = 0; e < 8; ++e) { const int c = colt - 1024 + bj * HALF + e; lbv[bj][e] = 1.0f / (1.0f + __expf(lbl[1024 + c] - lbl[c])); }
#pragma unroll
            for (int ai = 0; ai < 2; ++ai)
#pragma unroll
                for (int m = 0; m < 4; ++m) { float* rowp = LOGF + (size_t)(row0 + ai * HALF + m * 16) * 1024 + (colt - 1024);
#pragma unroll
                    for (int bj = 0; bj < 2; ++bj)
#pragma unroll
                        for (int n = 0; n < 2; ++n) { f32x4 z = acc[ai][bj][m][n], o;
#pragma unroll
                            for (int e = 0; e < 4; ++e) { const float lb = lbv[bj][4 * n + e]; const float sg = 1.0f / (1.0f + __expf(-z[e])); o[e] = __logf(lb + (1.0f - lb) * sg); }
                            *(f32x4*)(rowp + bj * HALF + 4 * n) = o; } }
        } else {
            const int type = (pn < 4) ? 1 : (pn < 12) ? 0 : (pn < 16) ? 1 : (pn < 22) ? 0 : 2;
            const int pcol = (pn < 4) ? colt : colt - 1024;
#pragma unroll
            for (int ai = 0; ai < 2; ++ai)
#pragma unroll
                for (int m = 0; m < 4; ++m) { bf16_t* rowp = P + (size_t)(row0 + ai * HALF + m * 16) * PLD + pcol;
#pragma unroll
                    for (int bj = 0; bj < 2; ++bj) { float v[8];
#pragma unroll
                        for (int e = 0; e < 8; ++e) v[e] = acc[ai][bj][m][e >> 2][e & 3];
                        if (type != 0) {
#pragma unroll
                            for (int e = 0; e < 8; ++e) { const float sg = __builtin_amdgcn_rcpf(1.0f + __expf(-v[e])); v[e] = (type == 1) ? v[e] * sg : sg; } }
                        u32x4 w; w.x = cvt_pk_bf16(v[0], v[1]); w.y = cvt_pk_bf16(v[2], v[3]); w.z = cvt_pk_bf16(v[4], v[5]); w.w = cvt_pk_bf16(v[6], v[7]);
                        *(u32x4*)(rowp + bj * HALF) = w; } }
        }
    }
};
struct EpiMerge {
    static constexpr bool PERM = true, AFTER_DRAIN = false;
    const bf16_t* P; bf16_t* MG;
    __device__ __forceinline__ void operator()(const f32x4 (&acc)[2][2][4][2], const Unit& u, int wr, int wc, int fr, int fq) const {
        const int br = u.pm >= 64 ? 1 : 0, pm = u.pm & 63, pn = u.pn & 7;
        const int row0 = pm * BM + wr * 64 + fr, col0 = pn * BM + wc * 32 + 8 * fq, gcol = (br ? 4608 : 6656) + col0;
#pragma unroll
        for (int ai = 0; ai < 2; ++ai)
#pragma unroll
            for (int m = 0; m < 4; ++m) { const size_t row = (size_t)(row0 + ai * HALF + m * 16);
#pragma unroll
                for (int bj = 0; bj < 2; ++bj) {
                    const u32x4 g = __builtin_nontemporal_load((const u32x4*)(P + row * PLD + gcol + bj * HALF));
                    bf16_t* mp = MG + row * 2048 + col0 + bj * HALF;
                    float v[8];
                    v[0] = acc[ai][bj][m][0][0] * bflo(g.x); v[1] = acc[ai][bj][m][0][1] * bfhi(g.x); v[2] = acc[ai][bj][m][0][2] * bflo(g.y); v[3] = acc[ai][bj][m][0][3] * bfhi(g.y);
                    v[4] = acc[ai][bj][m][1][0] * bflo(g.z); v[5] = acc[ai][bj][m][1][1] * bfhi(g.z); v[6] = acc[ai][bj][m][1][2] * bflo(g.w); v[7] = acc[ai][bj][m][1][3] * bfhi(g.w);
                    if (br) { const u32x4 p = *(const u32x4*)mp;
                        v[0] += bflo(p.x); v[1] += bfhi(p.x); v[2] += bflo(p.y); v[3] += bfhi(p.y); v[4] += bflo(p.z); v[5] += bfhi(p.z); v[6] += bflo(p.w); v[7] += bfhi(p.w); }
                    u32x4 w; w.x = cvt_pk_bf16(v[0], v[1]); w.y = cvt_pk_bf16(v[2], v[3]); w.z = cvt_pk_bf16(v[4], v[5]); w.w = cvt_pk_bf16(v[6], v[7]);
                    *(u32x4*)mp = w; } }
    }
};
template <int WG> struct StaticOrderW {
    int nM, nN, nwg, G, c;
    __device__ void init(int M, int N, int G_, int c_) { nM = M / BM; nN = N / BM; nwg = nM * nN; G = G_; c = c_; }
    __device__ bool next(int i, Unit& u) const {
        const long L = (long)i * G + c; if (L >= nwg) return false;
        int wgid = (int)L; { const int q = nwg / NXCD, r = nwg % NXCD, xcd = wgid % NXCD, off = wgid / NXCD; wgid = (xcd < r ? xcd * (q + 1) : r * (q + 1) + (xcd - r) * q) + off; }
        const int nig = WG * nN, gid = wgid / nig, fm = gid * WG, gsz = (nM - fm) < WG ? (nM - fm) : WG;
        u.pm = fm + ((wgid % nig) % gsz); u.pn = (wgid % nig) / gsz; return true;
    }
    __device__ __forceinline__ void a_ready(const Unit&) const {}
    __device__ __forceinline__ void done(const Unit&) const {}
};
struct PairOrder {
    StaticOrderW<4> base;
    __device__ __forceinline__ bool next(int i, Unit& u) const { if (!base.next(i >> 1, u)) return false; if (i & 1) { u.pm += 64; u.pn += 8; } return true; }
    __device__ __forceinline__ void a_ready(const Unit&) const {}
    __device__ __forceinline__ void done(const Unit&) const {}
};
struct EpiRes {
    static constexpr bool PERM = false, AFTER_DRAIN = false;
    const float* base; float* out; const float* gate;
    __device__ __forceinline__ void operator()(const f32x4 (&acc)[2][2][4][2], const Unit& u, int wr, int wc, int fr, int fq) const {
        const int row0 = u.pm * BM + wr * 64 + fr, col0 = u.pn * BM + wc * 32 + 4 * fq, b = (u.pm * BM) >> 12;
        f32x4 gv[2][2];
#pragma unroll
        for (int bj = 0; bj < 2; ++bj)
#pragma unroll
            for (int n = 0; n < 2; ++n) gv[bj][n] = *(const f32x4*)(gate + (size_t)b * 12288 + col0 + bj * HALF + n * 16);
#pragma unroll
        for (int ai = 0; ai < 2; ++ai)
#pragma unroll
            for (int m = 0; m < 4; ++m) { const size_t off = (size_t)(row0 + ai * HALF + m * 16) * 2048 + col0;
#pragma unroll
                for (int bj = 0; bj < 2; ++bj)
#pragma unroll
                    for (int n = 0; n < 2; ++n) { const f32x4 bs = __builtin_nontemporal_load((const f32x4*)(base + off + bj * HALF + n * 16));
                        *(f32x4*)(out + off + bj * HALF + n * 16) = bs + gv[bj][n] * acc[ai][bj][m][n]; } }
    }
};
struct EpiRelu2 {
    static constexpr bool PERM = true, AFTER_DRAIN = false;
    bf16_t* O; int ldc;
    __device__ __forceinline__ void operator()(const f32x4 (&acc)[2][2][4][2], const Unit& u, int wr, int wc, int fr, int fq) const {
        const int row0 = u.pm * BM + wr * 64 + fr, col0 = u.pn * BM + wc * 32 + 8 * fq;
#pragma unroll
        for (int ai = 0; ai < 2; ++ai)
#pragma unroll
            for (int m = 0; m < 4; ++m) { bf16_t* rowp = O + (size_t)(row0 + ai * HALF + m * 16) * ldc + col0;
#pragma unroll
                for (int bj = 0; bj < 2; ++bj) { float v[8];
#pragma unroll
                    for (int e = 0; e < 8; ++e) { const float x = fmaxf(acc[ai][bj][m][e >> 2][e & 3], 0.f); v[e] = x * x; }
                    u32x4 w; w.x = cvt_pk_bf16(v[0], v[1]); w.y = cvt_pk_bf16(v[2], v[3]); w.z = cvt_pk_bf16(v[4], v[5]); w.w = cvt_pk_bf16(v[6], v[7]);
                    *(u32x4*)(rowp + bj * HALF) = w; } }
    }
};

struct EpiRes2 {
    static constexpr bool PERM = false, AFTER_DRAIN = false;
    const float* base; float* out; const float* mod; const float* g2; bf16_t* A2; float* rowss;
    __device__ __forceinline__ void operator()(const f32x4 (&acc)[2][2][4][2], const Unit& u, int wr, int wc, int fr, int fq) const {
        const int row0 = u.pm * BM + wr * 64 + fr, col0 = u.pn * BM + wc * 32 + 4 * fq, b = (u.pm * BM) >> 12;
        f32x4 gv[2][2], Gv[2][2];
#pragma unroll
        for (int bj = 0; bj < 2; ++bj)
#pragma unroll
            for (int n = 0; n < 2; ++n) { const int c = col0 + bj * HALF + n * 16; gv[bj][n] = *(const f32x4*)(mod + (size_t)b * 12288 + 2 * 2048 + c);
                Gv[bj][n] = *(const f32x4*)(g2 + c) * (*(const f32x4*)(mod + (size_t)b * 12288 + 4 * 2048 + c) + 1.0f); }
#pragma unroll
        for (int ai = 0; ai < 2; ++ai)
#pragma unroll
            for (int m = 0; m < 4; ++m) { const int row = row0 + ai * HALF + m * 16; const size_t off = (size_t)row * 2048 + col0; float ss = 0.f;
#pragma unroll
                for (int bj = 0; bj < 2; ++bj)
#pragma unroll
                    for (int n = 0; n < 2; ++n) { const f32x4 bs = *(const f32x4*)(base + off + bj * HALF + n * 16); const f32x4 x1 = bs + gv[bj][n] * acc[ai][bj][m][n];
                        *(f32x4*)(out + off + bj * HALF + n * 16) = x1; ss += (x1.x * x1.x + x1.y * x1.y) + (x1.z * x1.z + x1.w * x1.w);
                        const f32x4 hh = x1 * Gv[bj][n]; u32x2 w; w.x = cvt_pk_bf16(hh.x, hh.y); w.y = cvt_pk_bf16(hh.z, hh.w); *(u32x2*)(A2 + off + bj * HALF + n * 16) = w; }
                ss += __shfl_xor(ss, 16); ss += __shfl_xor(ss, 32);
                if (fq == 0) __hip_atomic_fetch_add(rowss + row, ss, __ATOMIC_RELAXED, __HIP_MEMORY_SCOPE_AGENT); }
    }
};
struct EpiUp {
    static constexpr bool PERM = true, AFTER_DRAIN = false;
    bf16_t* O; int ldc; const float* rowss; const float* cb;
    __device__ __forceinline__ void operator()(const f32x4 (&acc)[2][2][4][2], const Unit& u, int wr, int wc, int fr, int fq) const {
        const int row0 = u.pm * BM + wr * 64 + fr, col0 = u.pn * BM + wc * 32 + 8 * fq, b = (u.pm * BM) >> 12;
        f32x4 cbv[2][2];
#pragma unroll
        for (int bj = 0; bj < 2; ++bj)
#pragma unroll
            for (int n = 0; n < 2; ++n) cbv[bj][n] = *(const f32x4*)(cb + (size_t)b * 8192 + col0 + bj * HALF + 4 * n);
#pragma unroll
        for (int ai = 0; ai < 2; ++ai)
#pragma unroll
            for (int m = 0; m < 4; ++m) { const int row = row0 + ai * HALF + m * 16; bf16_t* rowp = O + (size_t)row * ldc + col0;
                const float rstd = 1.0f / sqrtf(__hip_atomic_load(rowss + row, __ATOMIC_RELAXED, __HIP_MEMORY_SCOPE_AGENT) * (1.0f / 2048.0f) + 1e-6f);
#pragma unroll
                for (int bj = 0; bj < 2; ++bj) { float v[8];
#pragma unroll
                    for (int e = 0; e < 8; ++e) { const float x = fmaxf(acc[ai][bj][m][e >> 2][e & 3] * rstd + cbv[bj][e >> 2][e & 3], 0.f); v[e] = x * x; }
                    u32x4 w; w.x = cvt_pk_bf16(v[0], v[1]); w.y = cvt_pk_bf16(v[2], v[3]); w.z = cvt_pk_bf16(v[4], v[5]); w.w = cvt_pk_bf16(v[6], v[7]);
                    *(u32x4*)(rowp + bj * HALF) = w; } }
    }
};

struct EpiRes3 {
    static constexpr bool PERM = false, AFTER_DRAIN = false;
    const float* base; float* out; const float* mod; const float* g2; bf16_t* A2; float* part;
    __device__ __forceinline__ void operator()(const f32x4 (&acc)[2][2][4][2], const Unit& u, int wr, int wc, int fr, int fq) const {
        const int row0 = u.pm * BM + wr * 64 + fr, col0 = u.pn * BM + wc * 32 + 4 * fq, b = (u.pm * BM) >> 12;
        f32x4 gv[2][2], Gv[2][2];
#pragma unroll
        for (int bj = 0; bj < 2; ++bj)
#pragma unroll
            for (int n = 0; n < 2; ++n) { const int c = col0 + bj * HALF + n * 16; gv[bj][n] = *(const f32x4*)(mod + (size_t)b * 12288 + 2 * 2048 + c);
                Gv[bj][n] = *(const f32x4*)(g2 + c) * (*(const f32x4*)(mod + (size_t)b * 12288 + 4 * 2048 + c) + 1.0f); }
        float* prow = part + (size_t)(u.pn * 4 + wc) * 16384;
#pragma unroll
        for (int ai = 0; ai < 2; ++ai)
#pragma unroll
            for (int m = 0; m < 4; ++m) { const int row = row0 + ai * HALF + m * 16; const size_t off = (size_t)row * 2048 + col0; float ss = 0.f;
#pragma unroll
                for (int bj = 0; bj < 2; ++bj)
#pragma unroll
                    for (int n = 0; n < 2; ++n) { const f32x4 bs = __builtin_nontemporal_load((const f32x4*)(base + off + bj * HALF + n * 16)); const f32x4 x1 = bs + gv[bj][n] * acc[ai][bj][m][n];
                        *(f32x4*)(out + off + bj * HALF + n * 16) = x1; ss += (x1.x * x1.x + x1.y * x1.y) + (x1.z * x1.z + x1.w * x1.w);
                        const f32x4 hh = x1 * Gv[bj][n]; u32x2 w; w.x = cvt_pk_bf16(hh.x, hh.y); w.y = cvt_pk_bf16(hh.z, hh.w); *(u32x2*)(A2 + off + bj * HALF + n * 16) = w; }
                ss += __shfl_xor(ss, 16); ss += __shfl_xor(ss, 32);
                if (fq == 0) prow[row] = ss; }
    }
};
struct EpiUp2 {
    static constexpr bool PERM = true, AFTER_DRAIN = false;
    bf16_t* O; int ldc; const PG8_LAS float* rstd; const float* cb;
    __device__ __forceinline__ void operator()(const f32x4 (&acc)[2][2][4][2], const Unit& u, int wr, int wc, int fr, int fq) const {
        const int row0 = u.pm * BM + wr * 64 + fr, col0 = u.pn * BM + wc * 32 + 8 * fq, b = (u.pm * BM) >> 12;
        f32x4 cbv[2][2];
#pragma unroll
        for (int bj = 0; bj < 2; ++bj)
#pragma unroll
            for (int n = 0; n < 2; ++n) cbv[bj][n] = *(const f32x4*)(cb + (size_t)b * 8192 + col0 + bj * HALF + 4 * n);
#pragma unroll
        for (int ai = 0; ai < 2; ++ai)
#pragma unroll
            for (int m = 0; m < 4; ++m) { const int rl = wr * 64 + fr + ai * HALF + m * 16; bf16_t* rowp = O + (size_t)(u.pm * BM + rl) * ldc + col0;
                const float rs = rstd[((u.pm >> 2) & 1) * 256 + rl];
#pragma unroll
                for (int bj = 0; bj < 2; ++bj) { float v[8];
#pragma unroll
                    for (int e = 0; e < 8; ++e) { const float x = fmaxf(acc[ai][bj][m][e >> 2][e & 3] * rs + cbv[bj][e >> 2][e & 3], 0.f); v[e] = x * x; }
                    u32x4 w; w.x = cvt_pk_bf16(v[0], v[1]); w.y = cvt_pk_bf16(v[2], v[3]); w.z = cvt_pk_bf16(v[4], v[5]); w.w = cvt_pk_bf16(v[6], v[7]);
                    *(u32x4*)(rowp + bj * HALF) = w; } }
    }
};

struct InOrder {
    StaticOrderW<4> base;
    __device__ __forceinline__ bool next(int i, Unit& u) const { if (!base.next(i, u)) return false; const int p = u.pn;
        u.pn = p < 16 ? 22 + p : p < 20 ? p - 16 : p < 24 ? p - 20 + 12 : p < 28 ? p - 24 + 4 : p < 32 ? p - 28 + 8 : p - 32 + 16; return true; }
    __device__ __forceinline__ void a_ready(const Unit&) const {}
    __device__ __forceinline__ void done(const Unit&) const {}
};
template <class Epi, class Sched, bool ALIGN_EPI = false, bool SP2 = false>
__device__ __forceinline__ void gemm_phase(PG8_LAS unsigned char* lds, const Gemm g, const Sched& S, const Epi& E) {
    int tid_ = threadIdx.x; asm volatile("" : "+v"(tid_));
    const int tid = tid_, wid = __builtin_amdgcn_readfirstlane(tid >> 6), lane = tid & 63, wr = wid >> 2, wc = wid & 3, fr = lane & 15, fq = lane >> 4;
    const int K = g.K, nt = K / BK;
    unsigned voffA[2], voffB[2];
#pragma unroll
    for (int i = 0; i < 2; ++i) { int R, C; stage_rc(tid * 16 + i * 8192, R, C); const int Rb = Epi::PERM ? ((R & ~31) + perm32(R & 31)) : R;
        voffA[i] = (unsigned)(R * K + C) * 2u; voffB[i] = (unsigned)(Rb * K + C) * 2u; }
    const size_t kstep = (size_t)(BK * 2);
    const size_t hstep = (size_t)HALF * K * 2;
    const size_t tstep = 2 * hstep;
    const unsigned ldsw = (unsigned)wid * 1024u;
    const int aoff = lds_byte(wr * 64 + fr, fq * 8), boff = lds_byte(wc * 32 + fr, fq * 8);
#define PG8_SA(b, h) (((b) * 2 + (h)) * HTB)
#define PG8_SB(b, h) ((4 + (b) * 2 + (h)) * HTB)
#define PG8_STAGE(bufoff, gbase, voff) do { _Pragma("unroll") for (int _i = 0; _i < 2; ++_i) \
        __builtin_amdgcn_global_load_lds((const unsigned*)((const char*)(gbase) + (voff)[_i]), (PG8_LAS unsigned*)(lds + (bufoff) + ldsw + _i * 8192), 16, 0, 0); } while (0)
#define PG8_LDA(dst, b, h) do { _Pragma("unroll") for (int m = 0; m < 4; ++m) _Pragma("unroll") for (int k = 0; k < 2; ++k) dst[m][k] = *(const PG8_LAS bf16x8*)(lds + PG8_SA(b, h) + aoff + m * 2048 + k * 1024); } while (0)
#define PG8_LDB(dst, b, h) do { _Pragma("unroll") for (int n = 0; n < 2; ++n) _Pragma("unroll") for (int k = 0; k < 2; ++k) dst[n][k] = *(const PG8_LAS bf16x8*)(lds + PG8_SB(b, h) + boff + n * 2048 + k * 1024); } while (0)
#define PG8_MMA(ai, bj, At, Bt) do { __builtin_amdgcn_s_setprio(1); _Pragma("unroll") for (int m = 0; m < 4; ++m) _Pragma("unroll") for (int n = 0; n < 2; ++n) _Pragma("unroll") for (int k = 0; k < 2; ++k) \
        acc[ai][bj][m][n] = __builtin_amdgcn_mfma_f32_16x16x32_bf16(Bt[n][k], At[m][k], acc[ai][bj][m][n], 0, 0, 0); __builtin_amdgcn_s_setprio(0); } while (0)
#define PG8_WAIT_V(n) asm volatile("s_waitcnt vmcnt(" #n ")" ::: "memory")
#define PG8_WAIT_L(n) asm volatile("s_waitcnt lgkmcnt(" #n ")" ::: "memory")
#define PG8_BAR __builtin_amdgcn_s_barrier()
#define PG8_SCHED __builtin_amdgcn_sched_barrier(0)
    Unit cur, nxt; int ui = 0;
    if (!S.next(0, cur)) return;
    f32x4 acc[2][2][4][2];
#pragma unroll
    for (int a = 0; a < 2; ++a)
#pragma unroll
        for (int b = 0; b < 2; ++b)
#pragma unroll
            for (int m = 0; m < 4; ++m)
#pragma unroll
                for (int n = 0; n < 2; ++n) acc[a][b][m][n] = (f32x4){0.f, 0.f, 0.f, 0.f};
    bf16x8 At[4][2], B0[2][2], B1[2][2];
    const char* cA = (const char*)g.A + (size_t)cur.pm * tstep; const char* cB = (const char*)g.Bt + (size_t)cur.pn * tstep;
    S.a_ready(cur);
    if constexpr (SP2) {
        PG8_STAGE(PG8_SB(0, 0), cB, voffB); PG8_STAGE(PG8_SB(0, 1), cB + hstep, voffB); PG8_STAGE(PG8_SA(0, 0), cA, voffA); PG8_STAGE(PG8_SA(0, 1), cA + hstep, voffA);
        if (wr == 1) PG8_BAR;
        PG8_WAIT_V(2); PG8_BAR;
        PG8_STAGE(PG8_SB(1, 0), cB + kstep, voffB); PG8_STAGE(PG8_SA(1, 0), cA + kstep, voffA); PG8_STAGE(PG8_SB(1, 1), cB + hstep + kstep, voffB);
        PG8_WAIT_V(6); PG8_BAR;
    } else {
        PG8_STAGE(PG8_SB(0, 0), cB, voffB); PG8_STAGE(PG8_SA(0, 0), cA, voffA); PG8_STAGE(PG8_SB(0, 1), cB + hstep, voffB); PG8_STAGE(PG8_SA(0, 1), cA + hstep, voffA);
        if (wr == 1) PG8_BAR;
        PG8_WAIT_V(4); PG8_BAR;
        PG8_STAGE(PG8_SB(1, 0), cB + kstep, voffB); PG8_STAGE(PG8_SA(1, 0), cA + kstep, voffA); PG8_STAGE(PG8_SB(1, 1), cB + hstep + kstep, voffB);
        PG8_WAIT_V(6); PG8_BAR;
    }
    for (;;) {
        const bool has_next = S.next(ui + 1, nxt);
        const char* nA = has_next ? (const char*)g.A + (size_t)nxt.pm * tstep : cA; const char* nB = has_next ? (const char*)g.Bt + (size_t)nxt.pn * tstep : cB;
        for (int t = 0; t < nt; t += 2) {
            const bool last = (t == nt - 2);
            const char* a1 = cA + (size_t)(t + 1) * kstep;
            const char* a2 = last ? nA : cA + (size_t)(t + 2) * kstep; const char* b2 = last ? nB : cB + (size_t)(t + 2) * kstep;
            const char* a3 = a2 + kstep; const char* b3 = b2 + kstep;
            if (last && has_next) S.a_ready(nxt);
            if constexpr (SP2) {
            PG8_LDB(B0, 0, 0); PG8_LDB(B1, 0, 1); PG8_SCHED; PG8_LDA(At, 0, 0); PG8_STAGE(PG8_SA(1, 1), a1 + hstep, voffA);
            PG8_WAIT_V(8); PG8_WAIT_L(0); PG8_BAR; PG8_MMA(0, 0, At, B0); PG8_MMA(0, 1, At, B1); PG8_BAR; PG8_SCHED;
            PG8_LDA(At, 0, 1); PG8_STAGE(PG8_SB(0, 0), b2, voffB); PG8_STAGE(PG8_SB(0, 1), b2 + hstep, voffB); PG8_STAGE(PG8_SA(0, 0), a2, voffA);
            PG8_WAIT_V(8); PG8_WAIT_L(0); PG8_BAR; PG8_MMA(1, 0, At, B0); PG8_MMA(1, 1, At, B1); PG8_BAR; PG8_SCHED;
            PG8_LDB(B0, 1, 0); PG8_LDB(B1, 1, 1); PG8_SCHED; PG8_LDA(At, 1, 0); PG8_STAGE(PG8_SA(0, 1), a2 + hstep, voffA);
            PG8_WAIT_V(8); PG8_WAIT_L(0); PG8_BAR; PG8_MMA(0, 0, At, B0); PG8_MMA(0, 1, At, B1); PG8_BAR; PG8_SCHED;
            PG8_LDA(At, 1, 1); PG8_STAGE(PG8_SB(1, 0), b3, voffB); PG8_STAGE(PG8_SB(1, 1), b3 + hstep, voffB); PG8_STAGE(PG8_SA(1, 0), a3, voffA);
            PG8_WAIT_V(8); PG8_WAIT_L(0); PG8_BAR; PG8_MMA(1, 0, At, B0); PG8_MMA(1, 1, At, B1); PG8_BAR; PG8_SCHED;
            } else {
            PG8_LDB(B0, 0, 0); PG8_SCHED; PG8_LDA(At, 0, 0); PG8_STAGE(PG8_SA(1, 1), a1 + hstep, voffA);
            PG8_WAIT_L(8); PG8_BAR; PG8_WAIT_L(0); PG8_MMA(0, 0, At, B0); PG8_BAR; PG8_SCHED;
            PG8_LDB(B1, 0, 1); PG8_STAGE(PG8_SB(0, 0), b2, voffB);
            PG8_BAR; PG8_WAIT_L(0); PG8_MMA(0, 1, At, B1); PG8_BAR;
            PG8_LDA(At, 0, 1); PG8_STAGE(PG8_SA(0, 0), a2, voffA);
            PG8_BAR; PG8_WAIT_L(0); PG8_MMA(1, 0, At, B0); PG8_BAR; PG8_SCHED;
            PG8_STAGE(PG8_SB(0, 1), b2 + hstep, voffB);
            PG8_WAIT_V(6); PG8_BAR; PG8_MMA(1, 1, At, B1); PG8_BAR;
            PG8_LDB(B0, 1, 0); PG8_SCHED; PG8_LDA(At, 1, 0); PG8_STAGE(PG8_SA(0, 1), a2 + hstep, voffA);
            PG8_WAIT_L(8); PG8_BAR; PG8_WAIT_L(0); PG8_MMA(0, 0, At, B0); PG8_BAR; PG8_SCHED;
            PG8_LDB(B1, 1, 1); PG8_STAGE(PG8_SB(1, 0), b3, voffB);
            PG8_BAR; PG8_WAIT_L(0); PG8_MMA(0, 1, At, B1); PG8_BAR;
            PG8_LDA(At, 1, 1); PG8_STAGE(PG8_SA(1, 0), a3, voffA);
            PG8_BAR; PG8_WAIT_L(0); PG8_MMA(1, 0, At, B0); PG8_BAR; PG8_SCHED;
            PG8_STAGE(PG8_SB(1, 1), b3 + hstep, voffB);
            PG8_WAIT_V(6); PG8_BAR; PG8_MMA(1, 1, At, B1); PG8_BAR;
            }
        }
        if constexpr (ALIGN_EPI) { if (wr == 0) PG8_BAR; }
        if constexpr (!Epi::AFTER_DRAIN) { E(acc, cur, wr, wc, fr, fq); S.done(cur); }
        if (!has_next) break;
#pragma unroll
        for (int a = 0; a < 2; ++a)
#pragma unroll
            for (int b = 0; b < 2; ++b)
#pragma unroll
                for (int m = 0; m < 4; ++m)
#pragma unroll
                    for (int n = 0; n < 2; ++n) acc[a][b][m][n] = (f32x4){0.f, 0.f, 0.f, 0.f};
        cur = nxt; cA = nA; cB = nB; ++ui;
        if constexpr (ALIGN_EPI) { if (wr == 1) PG8_BAR; }
    }
    PG8_WAIT_V(0);
    if constexpr (!ALIGN_EPI) { if (wr == 0) PG8_BAR; }
    PG8_BAR;
    if constexpr (Epi::AFTER_DRAIN) { E.fused(acc, cur, wr, wc, fr, fq, lds, wid, lane); S.done(cur); }
#undef PG8_SA
#undef PG8_SB
#undef PG8_STAGE
#undef PG8_LDA
#undef PG8_LDB
#undef PG8_MMA
#undef PG8_WAIT_V
#undef PG8_WAIT_L
#undef PG8_BAR
#undef PG8_SCHED
}
}
#define LAS __attribute__((address_space(3)))
typedef unsigned short bf16_t;
typedef short bf16x8 __attribute__((ext_vector_type(8)));
typedef float f32x4 __attribute__((ext_vector_type(4)));
typedef unsigned u32x4 __attribute__((ext_vector_type(4)));
typedef unsigned u32x2 __attribute__((ext_vector_type(2)));
using pg8::cvt_pk_bf16; using pg8::bflo; using pg8::bfhi; using pg8::bf2f; using pg8::PLD;
constexpr int DM = 2048, SEQ = 4096, NB = 4, M = NB * SEQ, INW = 9728, HID = 8192, NMOD = 6 * DM;
constexpr float EPS = 1e-6f;
constexpr size_t MiB = 1u << 20;
constexpr size_t WS_MOD = 0, WS_WIN = 1 * MiB, WS_WAB = 39 * MiB, WS_WO = 47 * MiB, WS_W1 = 55 * MiB, WS_W2 = 87 * MiB, WS_H = 120 * MiB, WS_P = 184 * MiB, WS_SSEG = 456 * MiB, WS_DSEG = 472 * MiB, WS_H2 = 440 * MiB, WS_PART = 504 * MiB, WS_END = 506 * MiB;
constexpr size_t WS_CB = 256 * 1024;
constexpr size_t WS_BAR = 512 * 1024, BAR_BYTES = 16384, WS_ROWSS = WS_BAR + BAR_BYTES, ZERO_BYTES = BAR_BYTES + 65536;
constexpr int MISC_OFF = 147456 - 64;
constexpr int LDS_BYTES = 147456;
constexpr int NTHR = 512;

__device__ __forceinline__ float wave_sum(float v) {
#pragma unroll
    for (int o = 1; o < 64; o <<= 1) v += __shfl_xor(v, o);
    return v;
}
__device__ __forceinline__ bf16x8 ldfrag(const LAS bf16_t* base, int pitch, int row, int kofs) { return *(const LAS bf16x8*)(base + row * pitch + kofs); }
#define MFMA16(a, b, c) __builtin_amdgcn_mfma_f32_16x16x32_bf16((a), (b), (c), 0, 0, 0)
#define LBAR() do { asm volatile("s_waitcnt lgkmcnt(0)" ::: "memory"); __builtin_amdgcn_s_barrier(); asm volatile("" ::: "memory"); } while (0)
#define XB_TMO      128
#define XB_XCNT(j)  (256  + 64 * (j))
#define XB_XSUB(j)  (1280 + 64 * (j))
#define XB_XGEN(j)  (2304 + 64 * (j))
#define XB_TOP      3328
#define XB_TOPGEN   3392
#define XCD_BAR_WORDS 3456
#define XB_SPIN_CAP (1u << 18)

__device__ __forceinline__ unsigned xb_ld(unsigned* p)              { return __hip_atomic_load(p, __ATOMIC_RELAXED, __HIP_MEMORY_SCOPE_AGENT); }
__device__ __forceinline__ unsigned xb_add(unsigned* p, unsigned v) { return __hip_atomic_fetch_add(p, v, __ATOMIC_RELAXED, __HIP_MEMORY_SCOPE_AGENT); }
__device__ __forceinline__ unsigned xb_xcc_id() { return (unsigned)__builtin_amdgcn_s_getreg((3 << 11) | 20) & 0xFu; }
#define XB_SPIN(cond, bar) do { unsigned _sp = 0; while (cond) { __builtin_amdgcn_s_sleep(1); \
    if ((++_sp & 255u) == 0u) { if (xb_ld(&(bar)[XB_TMO])) break; if (_sp > XB_SPIN_CAP) { atomicAdd(&(bar)[XB_TMO], 1u); break; } } } } while (0)

struct XcdBarrier {
    unsigned* bar; unsigned x;
    volatile LAS unsigned* st;
};

__device__ __forceinline__ XcdBarrier xcd_barrier_post(unsigned* bar, volatile LAS unsigned* st) {
    XcdBarrier b; b.bar = bar; b.x = xb_xcc_id(); b.st = st;
    if (threadIdx.x == 0) (void)xb_add(&bar[XB_XCNT(b.x)], 1u);
    return b;
}
__device__ __forceinline__ void xcd_barrier_complete(unsigned* bar, unsigned x, unsigned& nloc, unsigned& nx) {
    const unsigned G = gridDim.x * gridDim.y * gridDim.z;
    unsigned sum, cnt, mine, sp = 0u;
    for (;;) {
        sum = 0u; cnt = 0u; mine = 0u;
#pragma unroll
        for (unsigned j = 0; j < 16; ++j) { const unsigned c = xb_ld(&bar[XB_XCNT(j)]); sum += c; cnt += (c > 0u) ? 1u : 0u; mine = (j == x) ? c : mine; }
        if (sum == G) break;
        __builtin_amdgcn_s_sleep(1);
        if ((++sp & 255u) == 0u) { if (xb_ld(&bar[XB_TMO])) break; if (sp > XB_SPIN_CAP) { atomicAdd(&bar[XB_TMO], 1u); break; } }
    }
    nloc = mine > 0u ? mine : 1u; nx = cnt > 0u ? cnt : 1u;
}

__device__ __forceinline__ void xcd_barrier(const XcdBarrier& b) {
    asm volatile("s_waitcnt vmcnt(0)" ::: "memory");
    __syncthreads();
    if (threadIdx.x == 0) {
        unsigned* bar = b.bar;
        __builtin_amdgcn_s_waitcnt(0);
        unsigned nloc = b.st[0], nx = b.st[1];
        if (nloc == 0u) { xcd_barrier_complete(bar, b.x, nloc, nx); b.st[0] = nloc; b.st[1] = nx; }
        const unsigned old = xb_add(&bar[XB_XSUB(b.x)], 1u);
        const unsigned gen = old / nloc;
        if (old + 1u == (gen + 1u) * nloc) {
            __builtin_amdgcn_fence(__ATOMIC_RELEASE, "agent");
            asm volatile("s_waitcnt vmcnt(0)" ::: "memory");
            const unsigned og = xb_add(&bar[XB_TOP], 1u);
            const unsigned tg = og / nx;
            if (og + 1u == (tg + 1u) * nx) xb_add(&bar[XB_TOPGEN], 1u);
            else XB_SPIN(xb_ld(&bar[XB_TOPGEN]) == tg, bar);
            __builtin_amdgcn_fence(__ATOMIC_ACQUIRE, "agent");
            xb_add(&bar[XB_XGEN(b.x)], 1u);
            asm volatile("s_waitcnt vmcnt(0)" ::: "memory");
        } else {
            XB_SPIN(xb_ld(&bar[XB_XGEN(b.x)]) == gen, bar);
            __builtin_amdgcn_fence(__ATOMIC_ACQUIRE, "agent");
            asm volatile("s_waitcnt vmcnt(0)" ::: "memory");
        }
    }
    __syncthreads();
}


struct TrDesc { const float* W; bf16_t* WT; int K, N, row_off, item; };
__device__ __forceinline__ void tr_load(const TrDesc& d, int lane, f32x4 (&v)[16]) {
    const int nkb = d.K / 64, kb = d.item % nkb, nb = d.item / nkb, k0 = 64 * kb, n0 = 64 * nb;
    const float* p = d.W + (size_t)(k0 + (lane >> 4)) * d.N + n0 + 4 * (lane & 15);
#pragma unroll
    for (int i = 0; i < 16; ++i) v[i] = __builtin_nontemporal_load((const f32x4*)(p + (size_t)(4 * i) * d.N));
}
__device__ __forceinline__ void tr_store(const TrDesc& d, int lane, const f32x4 (&v)[16], LAS float* scr) {
    const int nkb = d.K / 64, kb = d.item % nkb, nb = d.item / nkb, k0 = 64 * kb, n0 = 64 * nb;
#pragma unroll
    for (int i = 0; i < 16; ++i) { LAS float* s = scr + (4 * i + (lane >> 4)) * 65 + 4 * (lane & 15); s[0] = v[i].x; s[1] = v[i].y; s[2] = v[i].z; s[3] = v[i].w; }
    __builtin_amdgcn_wave_barrier();
    const int c = lane & 7;
#pragma unroll
    for (int j = 0; j < 8; ++j) { const int n = (lane >> 3) + 8 * j; const LAS float* s = scr + (8 * c) * 65 + n;
        u32x4 o; o.x = cvt_pk_bf16(s[0 * 65], s[1 * 65]); o.y = cvt_pk_bf16(s[2 * 65], s[3 * 65]); o.z = cvt_pk_bf16(s[4 * 65], s[5 * 65]); o.w = cvt_pk_bf16(s[6 * 65], s[7 * 65]);
        *(u32x4*)(d.WT + (size_t)(d.row_off + n0 + n) * d.K + k0 + 8 * c) = o; }
    __builtin_amdgcn_wave_barrier();
}
__device__ __forceinline__ void gemv_item(const float* __restrict__ cvec, const float* __restrict__ Wada, const float* __restrict__ bada, float* mod, LAS unsigned char* lds, int item, int tid) {
    LAS f32x4* sc = (LAS f32x4*)lds;
    LAS float* red = (LAS float*)(lds + 32768);
    for (int k = tid; k < DM; k += NTHR) { f32x4 v;
#pragma unroll
        for (int b = 0; b < 4; ++b) { const float x = cvec[b * DM + k]; v[b] = x / (1.0f + __expf(-x)); }
        sc[k] = v; }
    __syncthreads();
    const int c4 = tid % 12, rl = tid / 12, n0 = item * 48;
    f32x4 a0 = {0.f, 0.f, 0.f, 0.f}, a1 = a0, a2 = a0, a3 = a0;
    if (rl < 42) {
        const float* wp = Wada + n0 + 4 * c4;
#pragma unroll 8
        for (int k = rl; k < DM; k += 42) { const f32x4 w = __builtin_nontemporal_load((const f32x4*)(wp + (size_t)k * NMOD)); const f32x4 s = sc[k]; a0 += w * s.x; a1 += w * s.y; a2 += w * s.z; a3 += w * s.w; }
        LAS f32x4* r = (LAS f32x4*)red + (rl * 12 + c4) * 4; r[0] = a0; r[1] = a1; r[2] = a2; r[3] = a3;
    }
    __syncthreads();
    if (tid < 192) { const int b = tid / 48, col = tid % 48, cc = col >> 2, e = col & 3; float s = 0.f;
        for (int r = 0; r < 42; ++r) s += red[((r * 12 + cc) * 4 + b) * 4 + e];
        mod[(size_t)b * NMOD + n0 + col] = s + bada[n0 + col]; }
    __syncthreads();
}
__device__ __forceinline__ void norm_phase(const float* X, const float* __restrict__ gain, const float* mod, int sh_off, int sc_off, bf16_t* H, int gw, int NGW, int lane) {
    for (int rg = gw; rg < M / 8; rg += NGW) {
        const int row0 = rg * 8, b = row0 >> 12;
        f32x4 gs[8], sh[8];
#pragma unroll
        for (int j = 0; j < 8; ++j) { const f32x4 g = ((const f32x4*)gain)[lane + 64 * j]; const f32x4 s = ((const f32x4*)(mod + (size_t)b * NMOD + sc_off))[lane + 64 * j];
            gs[j] = g * (s + 1.0f); sh[j] = ((const f32x4*)(mod + (size_t)b * NMOD + sh_off))[lane + 64 * j]; }
        for (int r = 0; r < 8; ++r) {
            const f32x4* xr = (const f32x4*)(X + (size_t)(row0 + r) * DM) + lane;
            f32x4 v[8]; float ss = 0.f;
#pragma unroll
            for (int j = 0; j < 8; ++j) { v[j] = __builtin_nontemporal_load(xr + 64 * j); ss += (v[j].x * v[j].x + v[j].y * v[j].y) + (v[j].z * v[j].z + v[j].w * v[j].w); }
            const float rstd = 1.0f / sqrtf(wave_sum(ss) * (1.0f / DM) + EPS);
            u32x2* o8 = (u32x2*)(H + (size_t)(row0 + r) * DM) + lane;
#pragma unroll
            for (int j = 0; j < 8; ++j) { const f32x4 y = v[j] * rstd * gs[j] + sh[j]; u32x2 w; w.x = cvt_pk_bf16(y.x, y.y); w.y = cvt_pk_bf16(y.z, y.w); o8[64 * j] = w; }
        }
    }
}
__device__ __forceinline__ void bias_phase(const bf16_t* W1T, const float* mod, float* cb, int gw, int NGW, int lane) {
    for (int n = gw; n < HID; n += NGW) {
        float w[32];
#pragma unroll
        for (int j = 0; j < 4; ++j) { const u32x4 r = *(const u32x4*)(W1T + (size_t)n * DM + (j * 64 + lane) * 8);
            w[8 * j + 0] = bflo(r.x); w[8 * j + 1] = bfhi(r.x); w[8 * j + 2] = bflo(r.y); w[8 * j + 3] = bfhi(r.y); w[8 * j + 4] = bflo(r.z); w[8 * j + 5] = bfhi(r.z); w[8 * j + 6] = bflo(r.w); w[8 * j + 7] = bfhi(r.w); }
#pragma unroll
        for (int b = 0; b < 4; ++b) { const float* sh = mod + (size_t)b * NMOD + 3 * DM; float s = 0.f;
#pragma unroll
            for (int j = 0; j < 4; ++j) { const f32x4 s0 = *(const f32x4*)(sh + (j * 64 + lane) * 8), s1 = *(const f32x4*)(sh + (j * 64 + lane) * 8 + 4);
                s += (w[8 * j + 0] * s0.x + w[8 * j + 1] * s0.y) + (w[8 * j + 2] * s0.z + w[8 * j + 3] * s0.w) + (w[8 * j + 4] * s1.x + w[8 * j + 5] * s1.y) + (w[8 * j + 6] * s1.z + w[8 * j + 7] * s1.w); }
            s = wave_sum(s);
            if (lane == 0) cb[(size_t)b * HID + n] = s; }
    }
}
typedef float f32x2 __attribute__((ext_vector_type(2)));
typedef short v4i16_t __attribute__((ext_vector_type(4)));
template <bool FULL>
__device__ __forceinline__ void hgrn_seg(int b, int h, int sg, const bf16_t* P, const float* LOGF, const float* __restrict__ ogain, bf16_t* OA, float* SSEG, float* DSEG, LAS unsigned char* lds, int tid) {
    const int lane = tid & 63, wid = __builtin_amdgcn_readfirstlane(tid >> 6), fr = lane & 15, fq = lane >> 4;
    LAS bf16_t* Qd = (LAS bf16_t*)lds;
    LAS bf16_t* Kd = Qd + 64 * 136;
    LAS bf16_t* Qb = Kd + 64 * 136;
    LAS bf16_t* KlT = Qb + 64 * 136;
    LAS bf16_t* VT = KlT + 128 * 72;
    LAS bf16_t* Pm = VT + 128 * 72;
    LAS bf16_t* ST = Pm + 64 * 72;
    LAS float* segtot = (LAS float*)(ST + 128 * 136);
    LAS float* dec = segtot + 1024;
    LAS float* rsq = dec + 128;
    const int unit = (b * 8 + h) * 8 + sg;
    f32x4 sacc[8];
#pragma unroll
    for (int kt = 0; kt < 8; ++kt) sacc[kt] = (f32x4){0.f, 0.f, 0.f, 0.f};
    const int kp = lane, t0 = wid * 8;
    const int tt = wid & 3, vh = wid >> 2;
    f32x4 gn[4];
    if (FULL) {
        for (int j = 0; j < sg; ++j) { const int uj = unit - sg + j;
#pragma unroll
            for (int kt = 0; kt < 8; ++kt) { const f32x4 d = *(const f32x4*)(DSEG + (size_t)uj * 128 + kt * 16 + 4 * fq); const f32x4 sv = *(const f32x4*)(SSEG + ((size_t)uj * 8 + kt) * 2048 + tid * 4); sacc[kt] = sacc[kt] * d + sv; } }
#pragma unroll
        for (int kt = 0; kt < 8; ++kt) { u32x2 w; w.x = cvt_pk_bf16(sacc[kt][0], sacc[kt][1]); w.y = cvt_pk_bf16(sacc[kt][2], sacc[kt][3]);
            *(LAS u32x2*)(ST + (wid * 16 + fr) * 136 + kt * 16 + 4 * fq) = w; }
#pragma unroll
        for (int vt = 0; vt < 4; ++vt) gn[vt] = *(const f32x4*)(ogain + h * 128 + (vh * 4 + vt) * 16 + 4 * fq);
    }
    f32x2 dsum = {0.f, 0.f};
    f32x2 lf[8]; unsigned qv[8], vv[8];
    {   const size_t r0 = (size_t)b * SEQ + (size_t)(sg * 8) * 64;
#pragma unroll
        for (int j = 0; j < 8; ++j) { const size_t row = r0 + t0 + j; lf[j] = *(const f32x2*)(LOGF + row * 1024 + h * 128 + 2 * kp); vv[j] = *(const unsigned*)(P + row * PLD + 1024 + h * 128 + 2 * kp); if (FULL) qv[j] = *(const unsigned*)(P + row * PLD + h * 128 + 2 * kp); } }
    LBAR();
    for (int n = 0; n < 8; ++n) {
        const size_t r0 = (size_t)b * SEQ + (size_t)(sg * 8 + n) * 64;
        f32x2 cs[8];
        { f32x2 a = {0.f, 0.f};
#pragma unroll
          for (int j = 0; j < 8; ++j) { a += lf[j]; cs[j] = a; } }
        *(LAS f32x2*)(segtot + wid * 128 + 2 * kp) = cs[7];
        u32x2 gg[4];
        if (FULL) {
#pragma unroll
            for (int vt = 0; vt < 4; ++vt) gg[vt] = __builtin_nontemporal_load((const u32x2*)(P + (r0 + tt * 16 + fr) * PLD + 2048 + h * 128 + (vh * 4 + vt) * 16 + 4 * fq));
        }
        LBAR();
        f32x2 off = {0.f, 0.f}, bmid = {0.f, 0.f}, blast = {0.f, 0.f};
#pragma unroll
        for (int s8 = 0; s8 < 8; ++s8) { const f32x2 tv = *(const LAS f32x2*)(segtot + s8 * 128 + 2 * kp); if (s8 < wid) off += tv; if (s8 < 4) bmid += tv; blast += tv; }
        dsum += blast;
        f32x2 emid, elm;
        emid.x = __expf(bmid.x); emid.y = __expf(bmid.y); elm.x = __expf(blast.x - bmid.x); elm.y = __expf(blast.y - bmid.y);
        float kl0[8], kl1[8];
#pragma unroll
        for (int j = 0; j < 8; ++j) { const f32x2 bb = cs[j] + off;
            const float f0 = __expf(lf[j].x), f1 = __expf(lf[j].y), kk0 = 1.0f - f0, kk1 = 1.0f - f1;
            const float e0 = __expf(bb.x - bmid.x), e1 = __expf(bb.y - bmid.y), i0 = __expf(bmid.x - bb.x), i1 = __expf(bmid.y - bb.y);
            if (FULL) { const float q0 = bflo(qv[j]), q1 = bfhi(qv[j]);
                *(LAS unsigned*)(Qd + (t0 + j) * 136 + 2 * kp) = cvt_pk_bf16(q0 * e0, q1 * e1);
                *(LAS unsigned*)(Kd + (t0 + j) * 136 + 2 * kp) = cvt_pk_bf16(kk0 * i0, kk1 * i1);
                *(LAS unsigned*)(Qb + (t0 + j) * 136 + 2 * kp) = cvt_pk_bf16(q0 * e0 * emid.x, q1 * e1 * emid.y); }
            kl0[j] = kk0 * i0 * elm.x; kl1[j] = kk1 * i1 * elm.y; }
        { u32x4 w0, w1; w0.x = cvt_pk_bf16(kl0[0], kl0[1]); w0.y = cvt_pk_bf16(kl0[2], kl0[3]); w0.z = cvt_pk_bf16(kl0[4], kl0[5]); w0.w = cvt_pk_bf16(kl0[6], kl0[7]);
          w1.x = cvt_pk_bf16(kl1[0], kl1[1]); w1.y = cvt_pk_bf16(kl1[2], kl1[3]); w1.z = cvt_pk_bf16(kl1[4], kl1[5]); w1.w = cvt_pk_bf16(kl1[6], kl1[7]);
          *(LAS u32x4*)(KlT + (2 * kp) * 72 + t0) = w0; *(LAS u32x4*)(KlT + (2 * kp + 1) * 72 + t0) = w1;
          u32x4 v0, v1;
          v0.x = (vv[0] & 0xffffu) | (vv[1] << 16); v0.y = (vv[2] & 0xffffu) | (vv[3] << 16); v0.z = (vv[4] & 0xffffu) | (vv[5] << 16); v0.w = (vv[6] & 0xffffu) | (vv[7] << 16);
          v1.x = (vv[0] >> 16) | (vv[1] & 0xffff0000u); v1.y = (vv[2] >> 16) | (vv[3] & 0xffff0000u); v1.z = (vv[4] >> 16) | (vv[5] & 0xffff0000u); v1.w = (vv[6] >> 16) | (vv[7] & 0xffff0000u);
          *(LAS u32x4*)(VT + (2 * kp) * 72 + t0) = v0; *(LAS u32x4*)(VT + (2 * kp + 1) * 72 + t0) = v1; }
        if (wid == 0) { f32x2 dv; dv.x = __expf(blast.x); dv.y = __expf(blast.y); *(LAS f32x2*)(dec + 2 * kp) = dv; }
        if (n + 1 < 8) {
            const size_t r1 = r0 + 64;
#pragma unroll
            for (int j = 0; j < 8; ++j) { const size_t row = r1 + t0 + j; lf[j] = *(const f32x2*)(LOGF + row * 1024 + h * 128 + 2 * kp); vv[j] = *(const unsigned*)(P + row * PLD + 1024 + h * 128 + 2 * kp); if (FULL) qv[j] = *(const unsigned*)(P + row * PLD + h * 128 + 2 * kp); }
        }
        LBAR();
        f32x4 o[4];
        if (FULL) {
#pragma unroll
            for (int q = 0; q < 2; ++q) { const int id = wid * 2 + q, t2 = id >> 2, st = id & 3;
                f32x4 acc = {0.f, 0.f, 0.f, 0.f};
                if (st <= t2) {
#pragma unroll
                    for (int ks = 0; ks < 4; ++ks) acc = MFMA16(ldfrag(Kd, 136, st * 16 + fr, ks * 32 + 8 * fq), ldfrag(Qd, 136, t2 * 16 + fr, ks * 32 + 8 * fq), acc);
                }
                const int t = t2 * 16 + fr, s0 = st * 16 + 4 * fq;
                u32x2 w; w.x = cvt_pk_bf16(s0 + 0 <= t ? acc[0] : 0.f, s0 + 1 <= t ? acc[1] : 0.f); w.y = cvt_pk_bf16(s0 + 2 <= t ? acc[2] : 0.f, s0 + 3 <= t ? acc[3] : 0.f);
                *(LAS u32x2*)(Pm + t * 72 + s0) = w; }
            LBAR();
            float ss = 0.f;
#pragma unroll
            for (int vt = 0; vt < 4; ++vt) { const int vrow = (vh * 4 + vt) * 16 + fr; f32x4 acc = {0.f, 0.f, 0.f, 0.f};
#pragma unroll
                for (int ks = 0; ks < 2; ++ks) acc = MFMA16(ldfrag(VT, 72, vrow, ks * 32 + 8 * fq), ldfrag(Pm, 72, tt * 16 + fr, ks * 32 + 8 * fq), acc);
#pragma unroll
                for (int ks = 0; ks < 4; ++ks) acc = MFMA16(ldfrag(ST, 136, vrow, ks * 32 + 8 * fq), ldfrag(Qb, 136, tt * 16 + fr, ks * 32 + 8 * fq), acc);
                o[vt] = acc; ss += (acc[0] * acc[0] + acc[1] * acc[1]) + (acc[2] * acc[2] + acc[3] * acc[3]); }
            ss += __shfl_xor(ss, 16); ss += __shfl_xor(ss, 32);
            if (fq == 0) rsq[vh * 64 + tt * 16 + fr] = ss;
        }
#pragma unroll
        for (int kt = 0; kt < 8; ++kt) { const f32x4 d = *(const LAS f32x4*)(dec + kt * 16 + 4 * fq); f32x4 acc = sacc[kt] * d;
#pragma unroll
            for (int ks = 0; ks < 2; ++ks) acc = MFMA16(ldfrag(KlT, 72, kt * 16 + fr, ks * 32 + 8 * fq), ldfrag(VT, 72, wid * 16 + fr, ks * 32 + 8 * fq), acc);
            sacc[kt] = acc; }
        LBAR();
        if (FULL) {
            { const int t = tt * 16 + fr; const float rstd = 1.0f / sqrtf((rsq[t] + rsq[64 + t]) * (1.0f / 128.0f) + EPS); const size_t row = r0 + t;
#pragma unroll
              for (int vt = 0; vt < 4; ++vt) { const int v0 = h * 128 + (vh * 4 + vt) * 16 + 4 * fq; const u32x2 g = gg[vt];
                  u32x2 w; w.x = cvt_pk_bf16(o[vt][0] * rstd * gn[vt].x * bflo(g.x), o[vt][1] * rstd * gn[vt].y * bfhi(g.x)); w.y = cvt_pk_bf16(o[vt][2] * rstd * gn[vt].z * bflo(g.y), o[vt][3] * rstd * gn[vt].w * bfhi(g.y));
                  *(u32x2*)(OA + row * 1024 + v0) = w; } }
            if (n + 1 < 8) {
#pragma unroll
                for (int kt = 0; kt < 8; ++kt) { u32x2 w; w.x = cvt_pk_bf16(sacc[kt][0], sacc[kt][1]); w.y = cvt_pk_bf16(sacc[kt][2], sacc[kt][3]);
                    *(LAS u32x2*)(ST + (wid * 16 + fr) * 136 + kt * 16 + 4 * fq) = w; }
            }
        }
    }
    if (!FULL) {
#pragma unroll
        for (int kt = 0; kt < 8; ++kt) *(f32x4*)(SSEG + ((size_t)unit * 8 + kt) * 2048 + tid * 4) = sacc[kt];
        if (wid == 0) { f32x2 dv; dv.x = __expf(dsum.x); dv.y = __expf(dsum.y); *(f32x2*)(DSEG + (size_t)unit * 128 + 2 * kp) = dv; }
    }
    LBAR();
}
__device__ __forceinline__ void hgrn_state(int b, int h, int sg, const bf16_t* P, const float* LOGF, float* SSEG, float* DSEG, LAS unsigned char* lds, int tid) {
    const int lane = tid & 63, wid = __builtin_amdgcn_readfirstlane(tid >> 6), fr = lane & 15, fq = lane >> 4;
    LAS bf16_t* KlT = (LAS bf16_t*)lds;
    LAS bf16_t* VT = KlT + 128 * 136;
    LAS float* segtot = (LAS float*)(VT + 128 * 136);
    const int unit = (b * 8 + h) * 8 + sg, kp = lane, t0 = wid * 16;
    f32x4 sacc[8];
#pragma unroll
    for (int kt = 0; kt < 8; ++kt) sacc[kt] = (f32x4){0.f, 0.f, 0.f, 0.f};
    f32x2 carry = {0.f, 0.f};
    f32x2 lf[16]; unsigned vv[16];
    const size_t rseg = (size_t)b * SEQ + (size_t)sg * 512;
#pragma unroll
    for (int j = 0; j < 16; ++j) { const size_t row = rseg + 384 + t0 + j; lf[j] = *(const f32x2*)(LOGF + row * 1024 + h * 128 + 2 * kp); vv[j] = *(const unsigned*)(P + row * PLD + 1024 + h * 128 + 2 * kp); }
    for (int sb = 3; sb >= 0; --sb) {
        f32x2 suf[16];
        { f32x2 a = {0.f, 0.f};
#pragma unroll
          for (int j = 15; j >= 0; --j) { suf[j] = a; a += lf[j]; }
          *(LAS f32x2*)(segtot + wid * 128 + 2 * kp) = a; }
        LBAR();
        f32x2 after = carry, sub = {0.f, 0.f};
#pragma unroll
        for (int w = 0; w < 8; ++w) { const f32x2 tv = *(const LAS f32x2*)(segtot + w * 128 + 2 * kp); if (w > wid) after += tv; sub += tv; }
        carry += sub;
        float kl0[16], kl1[16];
#pragma unroll
        for (int j = 0; j < 16; ++j) { const f32x2 e = suf[j] + after; kl0[j] = (1.0f - __expf(lf[j].x)) * __expf(e.x); kl1[j] = (1.0f - __expf(lf[j].y)) * __expf(e.y); }
#pragma unroll
        for (int q = 0; q < 2; ++q) { u32x4 w0, w1, v0, v1;
            w0.x = cvt_pk_bf16(kl0[8 * q + 0], kl0[8 * q + 1]); w0.y = cvt_pk_bf16(kl0[8 * q + 2], kl0[8 * q + 3]); w0.z = cvt_pk_bf16(kl0[8 * q + 4], kl0[8 * q + 5]); w0.w = cvt_pk_bf16(kl0[8 * q + 6], kl0[8 * q + 7]);
            w1.x = cvt_pk_bf16(kl1[8 * q + 0], kl1[8 * q + 1]); w1.y = cvt_pk_bf16(kl1[8 * q + 2], kl1[8 * q + 3]); w1.z = cvt_pk_bf16(kl1[8 * q + 4], kl1[8 * q + 5]); w1.w = cvt_pk_bf16(kl1[8 * q + 6], kl1[8 * q + 7]);
            *(LAS u32x4*)(KlT + (2 * kp) * 136 + t0 + 8 * q) = w0; *(LAS u32x4*)(KlT + (2 * kp + 1) * 136 + t0 + 8 * q) = w1;
            v0.x = (vv[8 * q + 0] & 0xffffu) | (vv[8 * q + 1] << 16); v0.y = (vv[8 * q + 2] & 0xffffu) | (vv[8 * q + 3] << 16); v0.z = (vv[8 * q + 4] & 0xffffu) | (vv[8 * q + 5] << 16); v0.w = (vv[8 * q + 6] & 0xffffu) | (vv[8 * q + 7] << 16);
            v1.x = (vv[8 * q + 0] >> 16) | (vv[8 * q + 1] & 0xffff0000u); v1.y = (vv[8 * q + 2] >> 16) | (vv[8 * q + 3] & 0xffff0000u); v1.z = (vv[8 * q + 4] >> 16) | (vv[8 * q + 5] & 0xffff0000u); v1.w = (vv[8 * q + 6] >> 16) | (vv[8 * q + 7] & 0xffff0000u);
            *(LAS u32x4*)(VT + (2 * kp) * 136 + t0 + 8 * q) = v0; *(LAS u32x4*)(VT + (2 * kp + 1) * 136 + t0 + 8 * q) = v1; }
        if (sb > 0) {
#pragma unroll
            for (int j = 0; j < 16; ++j) { const size_t row = rseg + (size_t)(sb - 1) * 128 + t0 + j; lf[j] = *(const f32x2*)(LOGF + row * 1024 + h * 128 + 2 * kp); vv[j] = *(const unsigned*)(P + row * PLD + 1024 + h * 128 + 2 * kp); }
        }
        LBAR();
        bf16x8 vf[4];
#pragma unroll
        for (int ks = 0; ks < 4; ++ks) vf[ks] = ldfrag(VT, 136, wid * 16 + fr, ks * 32 + 8 * fq);
#pragma unroll
        for (int kt = 0; kt < 8; ++kt) { f32x4 acc = sacc[kt];
#pragma unroll
            for (int ks = 0; ks < 4; ++ks) acc = MFMA16(ldfrag(KlT, 136, kt * 16 + fr, ks * 32 + 8 * fq), vf[ks], acc);
            sacc[kt] = acc; }
        LBAR();
    }
#pragma unroll
    for (int kt = 0; kt < 8; ++kt) *(f32x4*)(SSEG + ((size_t)unit * 8 + kt) * 2048 + tid * 4) = sacc[kt];
    if (wid == 0) { f32x2 dv; dv.x = __expf(carry.x); dv.y = __expf(carry.y); *(f32x2*)(DSEG + (size_t)unit * 128 + 2 * kp) = dv; }
}
struct SwaRaw { u32x4 k[4], v[4], q[2]; };
__device__ __forceinline__ void swa_load(SwaRaw& R, int b, int kvh, int nb, const bf16_t* P, int tid) {
    const size_t rq0 = (size_t)b * SEQ + (size_t)nb * 128; const int ch = tid & 7;
#pragma unroll
    for (int p = 0; p < 4; ++p) { const int ki = (tid >> 3) + 64 * p; const bool valid = (nb > 0) || (ki >= 128);
        R.k[p] = (u32x4){0u, 0u, 0u, 0u}; R.v[p] = (u32x4){0u, 0u, 0u, 0u};
        if (valid) { const size_t row = rq0 - 128 + ki; R.k[p] = __builtin_nontemporal_load((const u32x4*)(P + row * PLD + 4096 + kvh * 64 + ch * 8)); R.v[p] = __builtin_nontemporal_load((const u32x4*)(P + row * PLD + 4352 + kvh * 64 + ch * 8)); } }
#pragma unroll
    for (int p = 0; p < 2; ++p) R.q[p] = __builtin_nontemporal_load((const u32x4*)(P + (rq0 + (tid >> 3) + 64 * p) * PLD + 3072 + (kvh * 4) * 64 + ch * 8));
}
__device__ __forceinline__ void swa_compute(SwaRaw& R, int b, int kvh, int nb, const bf16_t* P, const float* __restrict__ qg, const float* __restrict__ kg, const float* __restrict__ sinks, bf16_t* OB, LAS unsigned char* lds, int tid) {
    const int lane = tid & 63, wid = __builtin_amdgcn_readfirstlane(tid >> 6), fr = lane & 15, fq = lane >> 4;
    LAS bf16_t* Qs = (LAS bf16_t*)lds;
    LAS bf16_t* Ks = Qs + 128 * 72;
    LAS bf16_t* Vr = Ks + 256 * 72;
    LAS bf16_t* Pw = Vr + 256 * 72 + wid * (16 * 168);
    const size_t rq0 = (size_t)b * SEQ + (size_t)nb * 128;
    const int ch = tid & 7;
    {
        const f32x4 g0 = *(const f32x4*)(kg + ch * 8), g1 = *(const f32x4*)(kg + ch * 8 + 4);
#pragma unroll
        for (int p = 0; p < 4; ++p) { const int ki = (tid >> 3) + 64 * p; const u32x4 raw = R.k[p], rv = R.v[p];
            float x[8] = {bflo(raw.x), bfhi(raw.x), bflo(raw.y), bfhi(raw.y), bflo(raw.z), bfhi(raw.z), bflo(raw.w), bfhi(raw.w)};
            float ss = 0.f;
#pragma unroll
            for (int e = 0; e < 8; ++e) ss += x[e] * x[e];
            ss += __shfl_xor(ss, 1); ss += __shfl_xor(ss, 2); ss += __shfl_xor(ss, 4);
            const float rs = 1.0f / sqrtf(ss * (1.0f / 64.0f) + EPS);
            u32x4 w; w.x = cvt_pk_bf16(x[0] * rs * g0.x, x[1] * rs * g0.y); w.y = cvt_pk_bf16(x[2] * rs * g0.z, x[3] * rs * g0.w); w.z = cvt_pk_bf16(x[4] * rs * g1.x, x[5] * rs * g1.y); w.w = cvt_pk_bf16(x[6] * rs * g1.z, x[7] * rs * g1.w);
            *(LAS u32x4*)(Ks + ki * 72 + ch * 8) = w;
            *(LAS u32x4*)(Vr + ki * 72 + ch * 8) = rv; }
    }
    const f32x4 qg0 = *(const f32x4*)(qg + ch * 8), qg1 = *(const f32x4*)(qg + ch * 8 + 4);
    const int kt0 = wid > 0 ? wid - 1 : 0;
    for (int g = 0; g < 4; ++g) {
        const int hq = kvh * 4 + g;
#pragma unroll
        for (int p = 0; p < 2; ++p) { const int row = (tid >> 3) + 64 * p; const u32x4 raw = R.q[p];
            float x[8] = {bflo(raw.x), bfhi(raw.x), bflo(raw.y), bfhi(raw.y), bflo(raw.z), bfhi(raw.z), bflo(raw.w), bfhi(raw.w)};
            float ss = 0.f;
#pragma unroll
            for (int e = 0; e < 8; ++e) ss += x[e] * x[e];
            ss += __shfl_xor(ss, 1); ss += __shfl_xor(ss, 2); ss += __shfl_xor(ss, 4);
            const float rs = 0.125f / sqrtf(ss * (1.0f / 64.0f) + EPS);
            u32x4 w; w.x = cvt_pk_bf16(x[0] * rs * qg0.x, x[1] * rs * qg0.y); w.y = cvt_pk_bf16(x[2] * rs * qg0.z, x[3] * rs * qg0.w); w.z = cvt_pk_bf16(x[4] * rs * qg1.x, x[5] * rs * qg1.y); w.w = cvt_pk_bf16(x[6] * rs * qg1.z, x[7] * rs * qg1.w);
            *(LAS u32x4*)(Qs + row * 72 + ch * 8) = w; }
        if (g < 3) {
#pragma unroll
            for (int p = 0; p < 2; ++p) R.q[p] = __builtin_nontemporal_load((const u32x4*)(P + (rq0 + (tid >> 3) + 64 * p) * PLD + 3072 + (hq + 1) * 64 + ch * 8));
        }
        LBAR();
        f32x4 s[10];
#pragma unroll
        for (int j = 0; j < 10; ++j) { f32x4 acc = {0.f, 0.f, 0.f, 0.f};
#pragma unroll
            for (int ks = 0; ks < 2; ++ks) acc = MFMA16(ldfrag(Ks, 72, (kt0 + j) * 16 + fr, ks * 32 + 8 * fq), ldfrag(Qs, 72, wid * 16 + fr, ks * 32 + 8 * fq), acc);
            s[j] = acc; }
        const int qi = wid * 16 + fr; const float sink = sinks[hq]; float m = sink;
#pragma unroll
        for (int j = 0; j < 10; ++j)
#pragma unroll
            for (int r = 0; r < 4; ++r) { const int ki = (kt0 + j) * 16 + 4 * fq + r; const bool valid = (ki > qi) && (ki <= qi + 128) && ((nb > 0) || (ki >= 128));
                s[j][r] = valid ? s[j][r] : -INFINITY; m = fmaxf(m, s[j][r]); }
        m = fmaxf(m, __shfl_xor(m, 16)); m = fmaxf(m, __shfl_xor(m, 32));
        float sum = 0.f;
#pragma unroll
        for (int j = 0; j < 10; ++j) {
#pragma unroll
            for (int r = 0; r < 4; ++r) { s[j][r] = __expf(s[j][r] - m); sum += s[j][r]; }
            u32x2 w; w.x = cvt_pk_bf16(s[j][0], s[j][1]); w.y = cvt_pk_bf16(s[j][2], s[j][3]);
            *(LAS u32x2*)(Pw + fr * 168 + j * 16 + 4 * fq) = w; }
        sum += __shfl_xor(sum, 16); sum += __shfl_xor(sum, 32);
        const float inv = 1.0f / (sum + __expf(sink - m));
        asm volatile("s_waitcnt lgkmcnt(0)" ::: "memory"); __builtin_amdgcn_wave_barrier();
#pragma unroll
        for (int dt = 0; dt < 4; ++dt) { f32x4 acc = {0.f, 0.f, 0.f, 0.f};
#pragma unroll
            for (int ks = 0; ks < 5; ++ks) { const LAS bf16_t* vp = Vr + (kt0 * 16 + ks * 32 + 8 * fq + (fr >> 2)) * 72 + dt * 16 + 4 * (fr & 3);
                const v4i16_t lo = __builtin_amdgcn_ds_read_tr16_b64_v4i16((LAS v4i16_t*)vp), hi = __builtin_amdgcn_ds_read_tr16_b64_v4i16((LAS v4i16_t*)(vp + 4 * 72));
                const bf16x8 vf = {lo[0], lo[1], lo[2], lo[3], hi[0], hi[1], hi[2], hi[3]};
                acc = MFMA16(vf, ldfrag(Pw, 168, fr, ks * 32 + 8 * fq), acc); }
            u32x2 w; w.x = cvt_pk_bf16(acc[0] * inv, acc[1] * inv); w.y = cvt_pk_bf16(acc[2] * inv, acc[3] * inv);
            *(u32x2*)(OB + (rq0 + qi) * 1024 + hq * 64 + dt * 16 + 4 * fq) = w; }
        LBAR();
    }
}

struct Args { const float* in[17]; float* out; unsigned char* ws; };
__global__ void __launch_bounds__(NTHR, 2) fwd_megakernel(Args a) {
    extern __shared__ __attribute__((aligned(16))) unsigned char lds_raw[];
    cg::grid_group grid = cg::this_grid();
    LAS unsigned char* lds = (LAS unsigned char*)lds_raw;
    const int tid = threadIdx.x, lane = tid & 63, wave = __builtin_amdgcn_readfirstlane(tid >> 6);
    const int G = gridDim.x, blk = blockIdx.x;
    const int vcu = (G % 8 == 0) ? (blk % 8) * (G / 8) + blk / 8 : blk;
    const int gw = vcu * 8 + wave, NGW = G * 8;
    const float *x = a.in[0], *cvec = a.in[1], *w_ada = a.in[2], *b_ada = a.in[3], *g1 = a.in[4], *w_in = a.in[5], *lbl = a.in[6], *ogain = a.in[7], *qg = a.in[8], *kg = a.in[9], *sinks = a.in[10],
                *w_a = a.in[11], *w_b = a.in[12], *w_o = a.in[13], *g2 = a.in[14], *w1 = a.in[15], *w2 = a.in[16];
    unsigned char* ws = a.ws;
    float* mod = (float*)(ws + WS_MOD);
    bf16_t *WinT = (bf16_t*)(ws + WS_WIN), *WabT = (bf16_t*)(ws + WS_WAB), *WoT = (bf16_t*)(ws + WS_WO), *W1T = (bf16_t*)(ws + WS_W1), *W2T = (bf16_t*)(ws + WS_W2);
    bf16_t *H = (bf16_t*)(ws + WS_H), *P = (bf16_t*)(ws + WS_P), *U = (bf16_t*)(ws + WS_P);
    float* out = a.out;
    float* LOGF = out;
    bf16_t* OAB = (bf16_t*)(out + (size_t)M * 1024);
    float* SSEG = (float*)(ws + WS_SSEG); float* DSEG = (float*)(ws + WS_DSEG);
    bf16_t* H2 = (bf16_t*)(ws + WS_H2); float* cb = (float*)(ws + WS_CB); float* part = (float*)(ws + WS_PART);
    volatile LAS unsigned* MISC = (volatile LAS unsigned*)(lds + MISC_OFF);
    if (tid < 16) MISC[tid] = 0u;
    __syncthreads();
    XcdBarrier bar = xcd_barrier_post((unsigned*)(ws + WS_BAR), MISC + 8);
#define GRID_SYNC() xcd_barrier(bar)
    if (a.ws == nullptr) grid.sync();

    for (int it = blk; it < NMOD / 48; it += G) gemv_item(cvec, w_ada, b_ada, mod, lds, it, tid);
    LAS float* scr = (LAS float*)(lds + wave * 16640);
    constexpr int I_IN = (DM / 64) * (INW / 64), I_A = (1024 / 64) * (DM / 64), I_O = (DM / 64) * (DM / 64), I_1 = (DM / 64) * (HID / 64), I_2 = (HID / 64) * (DM / 64);
    constexpr int NP0 = I_IN + 2 * I_A + I_O, NITEMS = NP0 + I_1 + I_2;
    {
#define TR_DECODE(it_, d_) do { int r_ = (it_); \
            if (r_ < I_IN) { d_ = TrDesc{w_in, WinT, DM, INW, 0, r_}; break; } r_ -= I_IN; \
            if (r_ < I_A) { d_ = TrDesc{w_b, WabT, 1024, DM, 0, r_}; break; } r_ -= I_A; \
            if (r_ < I_A) { d_ = TrDesc{w_a, WabT, 1024, DM, DM, r_}; break; } r_ -= I_A; \
            if (r_ < I_O) { d_ = TrDesc{w_o, WoT, DM, DM, 0, r_}; break; } r_ -= I_O; \
            if (r_ < I_1) { d_ = TrDesc{w1, W1T, DM, HID, 0, r_}; break; } r_ -= I_1; \
            d_ = TrDesc{w2, W2T, HID, DM, 0, r_}; } while (0)
#define TR_RUN(first_, stride_, hi_) do { int it = (first_); \
        if (it < (hi_)) { f32x4 va[16], vb[16]; TrDesc da, db; TR_DECODE(it, da); tr_load(da, lane, va); \
            for (;;) { const int it2 = it + (stride_); const bool h2 = it2 < (hi_); \
                if (h2) { TR_DECODE(it2, db); tr_load(db, lane, vb); } \
                tr_store(da, lane, va, scr); if (!h2) break; \
                const int it3 = it2 + (stride_); const bool h3 = it3 < (hi_); \
                if (h3) { TR_DECODE(it3, da); tr_load(da, lane, va); } \
                tr_store(db, lane, vb, scr); if (!h3) break; it = it3; } } } while (0)
        TR_RUN(gw, NGW, NP0);
    }
    GRID_SYNC();
    norm_phase(x, g1, mod, 0, DM, H, gw, NGW, lane);
    GRID_SYNC();
    {
        pg8::Gemm g{H, WinT, M, INW, DM}; pg8::InOrder S; S.base.init(M, INW, G, blk);
        pg8::EpiIn E{P, LOGF, lbl};
        pg8::gemm_phase<pg8::EpiIn, pg8::InOrder, true, true>(lds, g, S, E);
    }
    {
        constexpr int nwg = (M / 256) * (INW / 256);
        const int maxu = (nwg + G - 1) / G, first_idle = nwg - (maxu - 1) * G, n_idle = first_idle < G ? G - first_idle : 0;
        if (n_idle > 0) { if (blk >= first_idle) TR_RUN(NP0 + (blk - first_idle) * 8 + wave, n_idle * 8, NITEMS); }
        else TR_RUN(NP0 + gw, NGW, NITEMS);
    }
    GRID_SYNC();
    for (int u = blk; u < 256; u += G) { SwaRaw R; swa_load(R, u >> 7, (u >> 5) & 3, u & 31, P, tid);
        hgrn_state(u >> 6, (u >> 3) & 7, u & 7, P, LOGF, SSEG, DSEG, lds, tid);
        swa_compute(R, u >> 7, (u >> 5) & 3, u & 31, P, qg, kg, sinks, OAB, lds, tid); }
    if (G == 256) bias_phase(W1T, mod, cb, gw, NGW, lane);
    GRID_SYNC();
    for (int u = blk; u < 256; u += G) { const int us = 256 + u;
        hgrn_seg<true>(u >> 6, (u >> 3) & 7, u & 7, P, LOGF, ogain, OAB + (size_t)M * 1024, SSEG, DSEG, lds, tid);
        SwaRaw R; swa_load(R, us >> 7, (us >> 5) & 3, us & 31, P, tid);
        swa_compute(R, us >> 7, (us >> 5) & 3, us & 31, P, qg, kg, sinks, OAB, lds, tid); }
    GRID_SYNC();
    {
        pg8::Gemm g{OAB, WabT, 2 * M, 2 * DM, 1024}; pg8::PairOrder S; S.base.init(M, DM, G, blk);
        pg8::EpiMerge E{P, H};
        pg8::gemm_phase<pg8::EpiMerge, pg8::PairOrder, true, true>(lds, g, S, E);
    }
    GRID_SYNC();
    if (G == 256) {
    {
        pg8::Gemm g{H, WoT, M, DM, DM}; pg8::StaticOrderW<4> S; S.init(M, DM, G, blk);
        pg8::EpiRes3 E{x, out, mod, g2, H2, part};
        pg8::gemm_phase<pg8::EpiRes3, pg8::StaticOrderW<4>, true, true>(lds, g, S, E);
    }
    GRID_SYNC();
    {
        pg8::Gemm g{H2, W1T, M, HID, DM}; pg8::StaticOrderW<4> S; S.init(M, HID, G, blk);
        pg8::Unit u0; S.next(0, u0);
        LAS float* rstd = (LAS float*)(lds + 131072 + 1024);
        { const int row = ((u0.pm & ~4) | ((tid >> 8) << 2)) * 256 + (tid & 255); float sacc = 0.f;
#pragma unroll 8
          for (int j = 0; j < 32; ++j) sacc += part[(size_t)j * 16384 + row];
          rstd[tid] = 1.0f / sqrtf(sacc * (1.0f / DM) + EPS); }
        __syncthreads();
        pg8::EpiUp2 E{U, HID, rstd, cb};
        pg8::gemm_phase<pg8::EpiUp2, pg8::StaticOrderW<4>, true, true>(lds, g, S, E);
    }
    GRID_SYNC();
    } else {
    {
        pg8::Gemm g{H, WoT, M, DM, DM}; pg8::StaticOrder S; S.init(M, DM, G, blk);
        pg8::EpiRes E{x, out, mod + 2 * DM};
        pg8::gemm_phase<pg8::EpiRes, pg8::StaticOrder, true, true>(lds, g, S, E);
    }
    GRID_SYNC();
    norm_phase(out, g2, mod, 3 * DM, 4 * DM, H, gw, NGW, lane);
    GRID_SYNC();
    {
        pg8::Gemm g{H, W1T, M, HID, DM}; pg8::StaticOrder S; S.init(M, HID, G, blk);
        pg8::EpiRelu2 E{U, HID};
        pg8::gemm_phase<pg8::EpiRelu2, pg8::StaticOrder, true, true>(lds, g, S, E);
    }
    GRID_SYNC();
    }
    {
        pg8::Gemm g{U, W2T, M, DM, HID}; pg8::StaticOrderW<4> S; S.init(M, DM, G, blk);
        pg8::EpiRes E{out, out, mod + 5 * DM};
        pg8::gemm_phase<pg8::EpiRes, pg8::StaticOrderW<4>, true, true>(lds, g, S, E);
    }
}

extern "C" void kernel_launch(void* const* d_in, const int* in_sizes, int n_in, void* d_out, int out_size, void* d_ws, size_t ws_size, hipStream_t stream) {
    static int grid_blocks = 0;
    if (grid_blocks == 0) {
        if (n_in != 17 || out_size != M * DM || ws_size < WS_END) { fprintf(stderr, "kernel_launch: unexpected shapes (n_in %d out %d ws %zu)\n", n_in, out_size, ws_size); grid_blocks = -1; return; }
        int dev = 0, cus = 0, per_cu = 0;
        (void)hipGetDevice(&dev);
        (void)hipDeviceGetAttribute(&cus, hipDeviceAttributeMultiprocessorCount, dev);
        if (hipFuncSetAttribute((const void*)fwd_megakernel, hipFuncAttributeMaxDynamicSharedMemorySize, LDS_BYTES) != hipSuccess) { fprintf(stderr, "kernel_launch: hipFuncSetAttribute failed\n"); grid_blocks = -1; return; }
        if (hipOccupancyMaxActiveBlocksPerMultiprocessor(&per_cu, (const void*)fwd_megakernel, NTHR, LDS_BYTES) != hipSuccess || per_cu < 1) { fprintf(stderr, "kernel_launch: occupancy query says %d\n", per_cu); (void)hipGetLastError(); grid_blocks = -1; return; }
        grid_blocks = cus;
        fprintf(stderr, "kernel_launch: %d CUs, %d blocks/CU by occupancy, launching %d blocks\n", cus, per_cu, grid_blocks);
    }
    if (grid_blocks < 0) return;
    if (hipMemsetAsync((char*)d_ws + WS_BAR, 0, ZERO_BYTES, stream) != hipSuccess) { fprintf(stderr, "kernel_launch: memset failed\n"); return; }
    Args a{};
    for (int i = 0; i < 17; ++i) a.in[i] = (const float*)d_in[i];
    a.out = (float*)d_out; a.ws = (unsigned char*)d_ws;
    void* args[] = {&a};
    hipError_t e = hipLaunchCooperativeKernel((const void*)fwd_megakernel, dim3(grid_blocks), dim3(NTHR), args, LDS_BYTES, stream);
    if (e != hipSuccess) fprintf(stderr, "cooperative launch failed: %s (grid %d)\n", hipGetErrorString(e), grid_blocks);
}
```

```cpp
#include <hip/hip_runtime.h>
#include <hip/hip_cooperative_groups.h>
#include <cstdio>
#include <cstdint>
namespace cg = cooperative_groups;
namespace pg8 {
#define PG8_LAS __attribute__((address_space(3)))
typedef unsigned short bf16_t;
typedef short bf16x8 __attribute__((ext_vector_type(8)));
typedef float f32x4 __attribute__((ext_vector_type(4)));
typedef unsigned u32x4 __attribute__((ext_vector_type(4)));
constexpr int BM = 256, BK = 64, HALF = 128, HTB = HALF * BK * 2  , STAGE_BYTES = 8 * HTB, NXCD = 8, WGM = 8;

__host__ __device__ __forceinline__ int lds_byte(int r, int c) { const int st = (r >> 4) * 2 + (c >> 5), rr = r & 15, cc = c & 31, ob = rr * 64 + cc * 2; return st * 1024 + (ob ^ (((ob >> 9) & 1) << 5)); }
__host__ __device__ __forceinline__ void stage_rc(int b, int& R, int& C) { const int st = b / 1024, sb = b % 1024, swz = sb ^ (((sb >> 9) & 1) << 5); R = (st >> 1) * 16 + swz / 64; C = (st & 1) * 32 + (swz % 64) / 2; }
__host__ __device__ __forceinline__ int perm32(int rho) { const int n = rho >> 4, i = rho & 15; return 8 * (i >> 2) + 4 * n + (i & 3); }

struct Unit { int pm, pn; };
struct Gemm { const bf16_t* A; const bf16_t* Bt; int M, N, K; };

struct StaticOrder {
    int nM, nN, nwg, G, c;
    __host__ __device__ void init(int M, int N, int G_, int c_) { nM = M / BM; nN = N / BM; nwg = nM * nN; G = G_; c = c_; }
    __host__ __device__ bool next(int i, Unit& u) const {
        const long L = (long)i * G + c; if (L >= nwg) return false;
        int wgid = (int)L; { const int q = nwg / NXCD, r = nwg % NXCD, xcd = wgid % NXCD, off = wgid / NXCD; wgid = (xcd < r ? xcd * (q + 1) : r * (q + 1) + (xcd - r) * q) + off; }
        const int nig = WGM * nN, gid = wgid / nig, fm = gid * WGM, gsz = (nM - fm) < WGM ? (nM - fm) : WGM;
        u.pm = fm + ((wgid % nig) % gsz); u.pn = (wgid % nig) / gsz; return true;
    }
    __device__ __forceinline__ void a_ready(const Unit&) const {}
    __device__ __forceinline__ void done(const Unit&) const {}
};

__device__ __forceinline__ unsigned cvt_pk_bf16(float lo, float hi) { unsigned r; asm volatile("v_cvt_pk_bf16_f32 %0, %1, %2" : "=v"(r) : "v"(lo), "v"(hi)); return r; }
typedef float f32x2 __attribute__((ext_vector_type(2)));
typedef unsigned u32x2 __attribute__((ext_vector_type(2)));
__device__ __forceinline__ float bf2f(unsigned short h) { return __uint_as_float((unsigned)h << 16); }
__device__ __forceinline__ float bflo(unsigned w) { return __uint_as_float(w << 16); }
__device__ __forceinline__ float bfhi(unsigned w) { return __uint_as_float(w & 0xffff0000u); }

constexpr int PLD = 8704;
struct EpiIn {
    static constexpr bool PERM = true, AFTER_DRAIN = false;
    bf16_t* P; float* LOGF; const float* lbl;
    __device__ __forceinline__ void operator()(const f32x4 (&acc)[2][2][4][2], const Unit& u, int wr, int wc, int fr, int fq) const {
        const int pn = u.pn, row0 = u.pm * BM + wr * 64 + fr, colt = pn * BM + wc * 32 + 8 * fq;
        if (pn >= 4 && pn < 8) {
            float lbv[2][8];
#pragma unroll
            for (int bj = 0; bj < 2; ++bj)
#pragma unroll
                for (int e = 0; e < 8; ++e) { const int c = colt - 1024 + bj * HALF + e; lbv[bj][e] = 1.0f / (1.0f + __expf(lbl[1024 + c] - lbl[c])); }
#pragma unroll
            for (int ai = 0; ai < 2; ++ai)
#pragma unroll
                for (int m = 0; m < 4; ++m) { float* rowp = LOGF + (size_t)(row0 + ai * HALF + m * 16) * 1024 + (colt - 1024);
#pragma unroll
                    for (int bj = 0; bj < 2; ++bj)
#pragma unroll
                        for (int n = 0; n < 2; ++n) { f32x4 z = acc[ai][bj][m][n], o;
#pragma unroll
                            for (int e = 0; e < 4; ++e) { const float lb = lbv[bj][4 * n + e]; const float sg = 1.0f / (1.0f + __expf(-z[e])); o[e] = __logf(lb + (1.0f - lb) * sg); }
                            *(f32x4*)(rowp + bj * HALF + 4 * n) = o; } }
        } else {
            const int type = (pn < 4) ? 1 : (pn < 12) ? 0 : (pn < 16) ? 1 : (pn < 22) ? 0 : 2;
            const int pcol = (pn < 4) ? colt : colt - 1024;
#pragma unroll
            for (int ai = 0; ai < 2; ++ai)
#pragma unroll
                for (int m = 0; m < 4; ++m) { bf16_t* rowp = P + (size_t)(row0 + ai * HALF + m * 16) * PLD + pcol;
#pragma unroll
                    for (int bj = 0; bj < 2; ++bj) { float v[8];
#pragma unroll
                        for (int e = 0; e < 8; ++e) v[e] = acc[ai][bj][m][e >> 2][e & 3];
                        if (type != 0) {
#pragma unroll
                            for (int e = 0; e < 8; ++e) { const float sg = __builtin_amdgcn_rcpf(1.0f + __expf(-v[e])); v[e] = (type == 1) ? v[e] * sg : sg; } }
                        u32x4 w; w.x = cvt_pk_bf16(v[0], v[1]); w.y = cvt_pk_bf16(v[2], v[3]); w.z = cvt_pk_bf16(v[4], v[5]); w.w = cvt_pk_bf16(v[6], v[7]);
                        *(u32x4*)(rowp + bj * HALF) = w; } }
        }
    }
};
struct EpiMerge {
    static constexpr bool PERM = true, AFTER_DRAIN = false;
    const bf16_t* P; bf16_t* MG;
    __device__ __forceinline__ void operator()(const f32x4 (&acc)[2][2][4][2], const Unit& u, int wr, int wc, int fr, int fq) const {
        const int br = u.pm >= 64 ? 1 : 0, pm = u.pm & 63, pn = u.pn & 7;
        const int row0 = pm * BM + wr * 64 + fr, col0 = pn * BM + wc * 32 + 8 * fq, gcol = (br ? 4608 : 6656) + col0;
#pragma unroll
        for (int ai = 0; ai < 2; ++ai)
#pragma unroll
            for (int m = 0; m < 4; ++m) { const size_t row = (size_t)(row0 + ai * HALF + m * 16);
#pragma unroll
                for (int bj = 0; bj < 2; ++bj) {
                    const u32x4 g = *(const u32x4*)(P + row * PLD + gcol + bj * HALF);
                    bf16_t* mp = MG + row * 2048 + col0 + bj * HALF;
                    float v[8];
                    v[0] = acc[ai][bj][m][0][0] * bflo(g.x); v[1] = acc[ai][bj][m][0][1] * bfhi(g.x); v[2] = acc[ai][bj][m][0][2] * bflo(g.y); v[3] = acc[ai][bj][m][0][3] * bfhi(g.y);
                    v[4] = acc[ai][bj][m][1][0] * bflo(g.z); v[5] = acc[ai][bj][m][1][1] * bfhi(g.z); v[6] = acc[ai][bj][m][1][2] * bflo(g.w); v[7] = acc[ai][bj][m][1][3] * bfhi(g.w);
                    if (br) { const u32x4 p = *(const u32x4*)mp;
                        v[0] += bflo(p.x); v[1] += bfhi(p.x); v[2] += bflo(p.y); v[3] += bfhi(p.y); v[4] += bflo(p.z); v[5] += bfhi(p.z); v[6] += bflo(p.w); v[7] += bfhi(p.w); }
                    u32x4 w; w.x = cvt_pk_bf16(v[0], v[1]); w.y = cvt_pk_bf16(v[2], v[3]); w.z = cvt_pk_bf16(v[4], v[5]); w.w = cvt_pk_bf16(v[6], v[7]);
                    *(u32x4*)mp = w; } }
    }
};
template <int WG> struct StaticOrderW {
    int nM, nN, nwg, G, c;
    __device__ void init(int M, int N, int G_, int c_) { nM = M / BM; nN = N / BM; nwg = nM * nN; G = G_; c = c_; }
    __device__ bool next(int i, Unit& u) const {
        const long L = (long)i * G + c; if (L >= nwg) return false;
        int wgid = (int)L; { const int q = nwg / NXCD, r = nwg % NXCD, xcd = wgid % NXCD, off = wgid / NXCD; wgid = (xcd < r ? xcd * (q + 1) : r * (q + 1) + (xcd - r) * q) + off; }
        const int nig = WG * nN, gid = wgid / nig, fm = gid * WG, gsz = (nM - fm) < WG ? (nM - fm) : WG;
        u.pm = fm + ((wgid % nig) % gsz); u.pn = (wgid % nig) / gsz; return true;
    }
    __device__ __forceinline__ void a_ready(const Unit&) const {}
    __device__ __forceinline__ void done(const Unit&) const {}
};
struct PairOrder {
    StaticOrderW<4> base;
    __device__ __forceinline__ bool next(int i, Unit& u) const { if (!base.next(i >> 1, u)) return false; if (i & 1) { u.pm += 64; u.pn += 8; } return true; }
    __device__ __forceinline__ void a_ready(const Unit&) const {}
    __device__ __forceinline__ void done(const Unit&) const {}
};
struct EpiRes {
    static constexpr bool PERM = false, AFTER_DRAIN = false;
    const float* base; float* out; const float* gate;
    __device__ __forceinline__ void operator()(const f32x4 (&acc)[2][2][4][2], const Unit& u, int wr, int wc, int fr, int fq) const {
        const int row0 = u.pm * BM + wr * 64 + fr, col0 = u.pn * BM + wc * 32 + 4 * fq, b = (u.pm * BM) >> 12;
        f32x4 gv[2][2];
#pragma unroll
        for (int bj = 0; bj < 2; ++bj)
#pragma unroll
            for (int n = 0; n < 2; ++n) gv[bj][n] = *(const f32x4*)(gate + (size_t)b * 12288 + col0 + bj * HALF + n * 16);
#pragma unroll
        for (int ai = 0; ai < 2; ++ai)
#pragma unroll
            for (int m = 0; m < 4; ++m) { const size_t off = (size_t)(row0 + ai * HALF + m * 16) * 2048 + col0;
#pragma unroll
                for (int bj = 0; bj < 2; ++bj)
#pragma unroll
                    for (int n = 0; n < 2; ++n) { const f32x4 bs = __builtin_nontemporal_load((const f32x4*)(base + off + bj * HALF + n * 16));
                        *(f32x4*)(out + off + bj * HALF + n * 16) = bs + gv[bj][n] * acc[ai][bj][m][n]; } }
    }
};
struct EpiRelu2 {
    static constexpr bool PERM = true, AFTER_DRAIN = false;
    bf16_t* O; int ldc;
    __device__ __forceinline__ void operator()(const f32x4 (&acc)[2][2][4][2], const Unit& u, int wr, int wc, int fr, int fq) const {
        const int row0 = u.pm * BM + wr * 64 + fr, col0 = u.pn * BM + wc * 32 + 8 * fq;
#pragma unroll
        for (int ai = 0; ai < 2; ++ai)
#pragma unroll
            for (int m = 0; m < 4; ++m) { bf16_t* rowp = O + (size_t)(row0 + ai * HALF + m * 16) * ldc + col0;
#pragma unroll
                for (int bj = 0; bj < 2; ++bj) { float v[8];
#pragma unroll
                    for (int e = 0; e < 8; ++e) { const float x = fmaxf(acc[ai][bj][m][e >> 2][e & 3], 0.f); v[e] = x * x; }
                    u32x4 w; w.x = cvt_pk_bf16(v[0], v[1]); w.y = cvt_pk_bf16(v[2], v[3]); w.z = cvt_pk_bf16(v[4], v[5]); w.w = cvt_pk_bf16(v[6], v[7]);
                    *(u32x4*)(rowp + bj * HALF) = w; } }
    }
};

struct EpiRes2 {
    static constexpr bool PERM = false, AFTER_DRAIN = false;
    const float* base; float* out; const float* mod; const float* g2; bf16_t* A2; float* rowss;
    __device__ __forceinline__ void operator()(const f32x4 (&acc)[2][2][4][2], const Unit& u, int wr, int wc, int fr, int fq) const {
        const int row0 = u.pm * BM + wr * 64 + fr, col0 = u.pn * BM + wc * 32 + 4 * fq, b = (u.pm * BM) >> 12;
        f32x4 gv[2][2], Gv[2][2];
#pragma unroll
        for (int bj = 0; bj < 2; ++bj)
#pragma unroll
            for (int n = 0; n < 2; ++n) { const int c = col0 + bj * HALF + n * 16; gv[bj][n] = *(const f32x4*)(mod + (size_t)b * 12288 + 2 * 2048 + c);
                Gv[bj][n] = *(const f32x4*)(g2 + c) * (*(const f32x4*)(mod + (size_t)b * 12288 + 4 * 2048 + c) + 1.0f); }
#pragma unroll
        for (int ai = 0; ai < 2; ++ai)
#pragma unroll
            for (int m = 0; m < 4; ++m) { const int row = row0 + ai * HALF + m * 16; const size_t off = (size_t)row * 2048 + col0; float ss = 0.f;
#pragma unroll
                for (int bj = 0; bj < 2; ++bj)
#pragma unroll
                    for (int n = 0; n < 2; ++n) { const f32x4 bs = *(const f32x4*)(base + off + bj * HALF + n * 16); const f32x4 x1 = bs + gv[bj][n] * acc[ai][bj][m][n];
                        *(f32x4*)(out + off + bj * HALF + n * 16) = x1; ss += (x1.x * x1.x + x1.y * x1.y) + (x1.z * x1.z + x1.w * x1.w);
                        const f32x4 hh = x1 * Gv[bj][n]; u32x2 w; w.x = cvt_pk_bf16(hh.x, hh.y); w.y = cvt_pk_bf16(hh.z, hh.w); *(u32x2*)(A2 + off + bj * HALF + n * 16) = w; }
                ss += __shfl_xor(ss, 16); ss += __shfl_xor(ss, 32);
                if (fq == 0) __hip_atomic_fetch_add(rowss + row, ss, __ATOMIC_RELAXED, __HIP_MEMORY_SCOPE_AGENT); }
    }
};
struct EpiUp {
    static constexpr bool PERM = true, AFTER_DRAIN = false;
    bf16_t* O; int ldc; const float* rowss; const float* cb;
    __device__ __forceinline__ void operator()(const f32x4 (&acc)[2][2][4][2], const Unit& u, int wr, int wc, int fr, int fq) const {
        const int row0 = u.pm * BM + wr * 64 + fr, col0 = u.pn * BM + wc * 32 + 8 * fq, b = (u.pm * BM) >> 12;
        f32x4 cbv[2][2];
#pragma unroll
        for (int bj = 0; bj < 2; ++bj)
#pragma unroll
            for (int n = 0; n < 2; ++n) cbv[bj][n] = *(const f32x4*)(cb + (size_t)b * 8192 + col0 + bj * HALF + 4 * n);
#pragma unroll
        for (int ai = 0; ai < 2; ++ai)
#pragma unroll
            for (int m = 0; m < 4; ++m) { const int row = row0 + ai * HALF + m * 16; bf16_t* rowp = O + (size_t)row * ldc + col0;
                const float rstd = 1.0f / sqrtf(__hip_atomic_load(rowss + row, __ATOMIC_RELAXED, __HIP_MEMORY_SCOPE_AGENT) * (1.0f / 2048.0f) + 1e-6f);
#pragma unroll
                for (int bj = 0; bj < 2; ++bj) { float v[8];
#pragma unroll
                    for (int e = 0; e < 8; ++e) { const float x = fmaxf(acc[ai][bj][m][e >> 2][e & 3] * rstd + cbv[bj][e >> 2][e & 3], 0.f); v[e] = x * x; }
                    u32x4 w; w.x = cvt_pk_bf16(v[0], v[1]); w.y = cvt_pk_bf16(v[2], v[3]); w.z = cvt_pk_bf16(v[4], v[5]); w.w = cvt_pk_bf16(v[6], v[7]);
                    *(u32x4*)(rowp + bj * HALF) = w; } }
    }
};

struct EpiRes3 {
    static constexpr bool PERM = false, AFTER_DRAIN = false;
    const float* base; float* out; const float* mod; const float* g2; bf16_t* A2; float* part;
    __device__ __forceinline__ void operator()(const f32x4 (&acc)[2][2][4][2], const Unit& u, int wr, int wc, int fr, int fq) const {
        const int row0 = u.pm * BM + wr * 64 + fr, col0 = u.pn * BM + wc * 32 + 4 * fq, b = (u.pm * BM) >> 12;
        f32x4 gv[2][2], Gv[2][2];
#pragma unroll
        for (int bj = 0; bj < 2; ++bj)
#pragma unroll
            for (int n = 0; n < 2; ++n) { const int c = col0 + bj * HALF + n * 16; gv[bj][n] = *(const f32x4*)(mod + (size_t)b * 12288 + 2 * 2048 + c);
                Gv[bj][n] = *(const f32x4*)(g2 + c) * (*(const f32x4*)(mod + (size_t)b * 12288 + 4 * 2048 + c) + 1.0f); }
        float* prow = part + (size_t)(u.pn * 4 + wc) * 16384;
#pragma unroll
        for (int ai = 0; ai < 2; ++ai)
#pragma unroll
            for (int m = 0; m < 4; ++m) { const int row = row0 + ai * HALF + m * 16; const size_t off = (size_t)row * 2048 + col0; float ss = 0.f;
#pragma unroll
                for (int bj = 0; bj < 2; ++bj)
#pragma unroll
                    for (int n = 0; n < 2; ++n) { const f32x4 bs = __builtin_nontemporal_load((const f32x4*)(base + off + bj * HALF + n * 16)); const f32x4 x1 = bs + gv[bj][n] * acc[ai][bj][m][n];
                        *(f32x4*)(out + off + bj * HALF + n * 16) = x1; ss += (x1.x * x1.x + x1.y * x1.y) + (x1.z * x1.z + x1.w * x1.w);
                        const f32x4 hh = x1 * Gv[bj][n]; u32x2 w; w.x = cvt_pk_bf16(hh.x, hh.y); w.y = cvt_pk_bf16(hh.z, hh.w); *(u32x2*)(A2 + off + bj * HALF + n * 16) = w; }
                ss += __shfl_xor(ss, 16); ss += __shfl_xor(ss, 32);
                if (fq == 0) prow[row] = ss; }
    }
};
struct EpiUp2 {
    static constexpr bool PERM = true, AFTER_DRAIN = false;
    bf16_t* O; int ldc; const PG8_LAS float* rstd; const float* cb;
    __device__ __forceinline__ void operator()(const f32x4 (&acc)[2][2][4][2], const Unit& u, int wr, int wc, int fr, int fq) const {
        const int row0 = u.pm * BM + wr * 64 + fr, col0 = u.pn * BM + wc * 32 + 8 * fq, b = (u.pm * BM) >> 12;
        f32x4 cbv[2][2];
#pragma unroll
        for (int bj = 0; bj < 2; ++bj)
#pragma unroll
            for (int n = 0; n < 2; ++n) cbv[bj][n] = *(const f32x4*)(cb + (size_t)b * 8192 + col0 + bj * HALF + 4 * n);
#pragma unroll
        for (int ai = 0; ai < 2; ++ai)
#pragma unroll
            for (int m = 0; m < 4; ++m) { const int rl = wr * 64 + fr + ai * HALF + m * 16; bf16_t* rowp = O + (size_t)(u.pm * BM + rl) * ldc + col0;
                const float rs = rstd[((u.pm >> 2) & 1) * 256 + rl];
#pragma unroll
                for (int bj = 0; bj < 2; ++bj) { float v[8];
#pragma unroll
                    for (int e = 0; e < 8; ++e) { const float x = fmaxf(acc[ai][bj][m][e >> 2][e & 3] * rs + cbv[bj][e >> 2][e & 3], 0.f); v[e] = x * x; }
                    u32x4 w; w.x = cvt_pk_bf16(v[0], v[1]); w.y = cvt_pk_bf16(v[2], v[3]); w.z = cvt_pk_bf16(v[4], v[5]); w.w = cvt_pk_bf16(v[6], v[7]);
                    *(u32x4*)(rowp + bj * HALF) = w; } }
    }
};

struct InOrder {
    StaticOrderW<4> base;
    __device__ __forceinline__ bool next(int i, Unit& u) const { if (!base.next(i, u)) return false; const int p = u.pn;
        u.pn = p < 16 ? 22 + p : p < 20 ? p - 16 : p < 24 ? p - 20 + 12 : p < 28 ? p - 24 + 4 : p < 32 ? p - 28 + 8 : p - 32 + 16; return true; }
    __device__ __forceinline__ void a_ready(const Unit&) const {}
    __device__ __forceinline__ void done(const Unit&) const {}
};
template <class Epi, class Sched, bool ALIGN_EPI = false, bool SP2 = false>
__device__ __forceinline__ void gemm_phase(PG8_LAS unsigned char* lds, const Gemm g, const Sched& S, const Epi& E) {
    int tid_ = threadIdx.x; asm volatile("" : "+v"(tid_));
    const int tid = tid_, wid = __builtin_amdgcn_readfirstlane(tid >> 6), lane = tid & 63, wr = wid >> 2, wc = wid & 3, fr = lane & 15, fq = lane >> 4;
    const int K = g.K, nt = K / BK;
    unsigned voffA[2], voffB[2];
#pragma unroll
    for (int i = 0; i < 2; ++i) { int R, C; stage_rc(tid * 16 + i * 8192, R, C); const int Rb = Epi::PERM ? ((R & ~31) + perm32(R & 31)) : R;
        voffA[i] = (unsigned)(R * K + C) * 2u; voffB[i] = (unsigned)(Rb * K + C) * 2u; }
    const size_t kstep = (size_t)(BK * 2);
    const size_t hstep = (size_t)HALF * K * 2;
    const size_t tstep = 2 * hstep;
    const unsigned ldsw = (unsigned)wid * 1024u;
    const int aoff = lds_byte(wr * 64 + fr, fq * 8), boff = lds_byte(wc * 32 + fr, fq * 8);
#define PG8_SA(b, h) (((b) * 2 + (h)) * HTB)
#define PG8_SB(b, h) ((4 + (b) * 2 + (h)) * HTB)
#define PG8_STAGE(bufoff, gbase, voff) do { _Pragma("unroll") for (int _i = 0; _i < 2; ++_i) \
        __builtin_amdgcn_global_load_lds((const unsigned*)((const char*)(gbase) + (voff)[_i]), (PG8_LAS unsigned*)(lds + (bufoff) + ldsw + _i * 8192), 16, 0, 0); } while (0)
#define PG8_LDA(dst, b, h) do { _Pragma("unroll") for (int m = 0; m < 4; ++m) _Pragma("unroll") for (int k = 0; k < 2; ++k) dst[m][k] = *(const PG8_LAS bf16x8*)(lds + PG8_SA(b, h) + aoff + m * 2048 + k * 1024); } while (0)
#define PG8_LDB(dst, b, h) do { _Pragma("unroll") for (int n = 0; n < 2; ++n) _Pragma("unroll") for (int k = 0; k < 2; ++k) dst[n][k] = *(const PG8_LAS bf16x8*)(lds + PG8_SB(b, h) + boff + n * 2048 + k * 1024); } while (0)
#define PG8_MMA(ai, bj, At, Bt) do { __builtin_amdgcn_s_setprio(1); _Pragma("unroll") for (int m = 0; m < 4; ++m) _Pragma("unroll") for (int n = 0; n < 2; ++n) _Pragma("unroll") for (int k = 0; k < 2; ++k) \
        acc[ai][bj][m][n] = __builtin_amdgcn_mfma_f32_16x16x32_bf16(Bt[n][k], At[m][k], acc[ai][bj][m][n], 0, 0, 0); __builtin_amdgcn_s_setprio(0); } while (0)
#define PG8_WAIT_V(n) asm volatile("s_waitcnt vmcnt(" #n ")" ::: "memory")
#define PG8_WAIT_L(n) asm volatile("s_waitcnt lgkmcnt(" #n ")" ::: "memory")
#define PG8_BAR __builtin_amdgcn_s_barrier()
#define PG8_SCHED __builtin_amdgcn_sched_barrier(0)
    Unit cur, nxt; int ui = 0;
    if (!S.next(0, cur)) return;
    f32x4 acc[2][2][4][2];
#pragma unroll
    for (int a = 0; a < 2; ++a)
#pragma unroll
        for (int b = 0; b < 2; ++b)
#pragma unroll
            for (int m = 0; m < 4; ++m)
#pragma unroll
                for (int n = 0; n < 2; ++n) acc[a][b][m][n] = (f32x4){0.f, 0.f, 0.f, 0.f};
    bf16x8 At[4][2], B0[2][2], B1[2][2];
    const char* cA = (const char*)g.A + (size_t)cur.pm * tstep; const char* cB = (const char*)g.Bt + (size_t)cur.pn * tstep;
    S.a_ready(cur);
    if constexpr (SP2) {
        PG8_STAGE(PG8_SB(0, 0), cB, voffB); PG8_STAGE(PG8_SB(0, 1), cB + hstep, voffB); PG8_STAGE(PG8_SA(0, 0), cA, voffA); PG8_STAGE(PG8_SA(0, 1), cA + hstep, voffA);
        if (wr == 1) PG8_BAR;
        PG8_WAIT_V(2); PG8_BAR;
        PG8_STAGE(PG8_SB(1, 0), cB + kstep, voffB); PG8_STAGE(PG8_SA(1, 0), cA + kstep, voffA); PG8_STAGE(PG8_SB(1, 1), cB + hstep + kstep, voffB);
        PG8_WAIT_V(6); PG8_BAR;
    } else {
        PG8_STAGE(PG8_SB(0, 0), cB, voffB); PG8_STAGE(PG8_SA(0, 0), cA, voffA); PG8_STAGE(PG8_SB(0, 1), cB + hstep, voffB); PG8_STAGE(PG8_SA(0, 1), cA + hstep, voffA);
        if (wr == 1) PG8_BAR;
        PG8_WAIT_V(4); PG8_BAR;
        PG8_STAGE(PG8_SB(1, 0), cB + kstep, voffB); PG8_STAGE(PG8_SA(1, 0), cA + kstep, voffA); PG8_STAGE(PG8_SB(1, 1), cB + hstep + kstep, voffB);
        PG8_WAIT_V(6); PG8_BAR;
    }
    for (;;) {
        const bool has_next = S.next(ui + 1, nxt);
        const char* nA = has_next ? (const char*)g.A + (size_t)nxt.pm * tstep : cA; const char* nB = has_next ? (const char*)g.Bt + (size_t)nxt.pn * tstep : cB;
        for (int t = 0; t < nt; t += 2) {
            const bool last = (t == nt - 2);
            const char* a1 = cA + (size_t)(t + 1) * kstep;
            const char* a2 = last ? nA : cA + (size_t)(t + 2) * kstep; const char* b2 = last ? nB : cB + (size_t)(t + 2) * kstep;
            const char* a3 = a2 + kstep; const char* b3 = b2 + kstep;
            if (last && has_next) S.a_ready(nxt);
            if constexpr (SP2) {
            PG8_LDB(B0, 0, 0); PG8_LDB(B1, 0, 1); PG8_SCHED; PG8_LDA(At, 0, 0); PG8_STAGE(PG8_SA(1, 1), a1 + hstep, voffA);
            PG8_WAIT_V(8); PG8_WAIT_L(0); PG8_BAR; PG8_MMA(0, 0, At, B0); PG8_MMA(0, 1, At, B1); PG8_BAR; PG8_SCHED;
            PG8_LDA(At, 0, 1); PG8_STAGE(PG8_SB(0, 0), b2, voffB); PG8_STAGE(PG8_SB(0, 1), b2 + hstep, voffB); PG8_STAGE(PG8_SA(0, 0), a2, voffA);
            PG8_WAIT_V(8); PG8_WAIT_L(0); PG8_BAR; PG8_MMA(1, 0, At, B0); PG8_MMA(1, 1, At, B1); PG8_BAR; PG8_SCHED;
            PG8_LDB(B0, 1, 0); PG8_LDB(B1, 1, 1); PG8_SCHED; PG8_LDA(At, 1, 0); PG8_STAGE(PG8_SA(0, 1), a2 + hstep, voffA);
            PG8_WAIT_V(8); PG8_WAIT_L(0); PG8_BAR; PG8_MMA(0, 0, At, B0); PG8_MMA(0, 1, At, B1); PG8_BAR; PG8_SCHED;
            PG8_LDA(At, 1, 1); PG8_STAGE(PG8_SB(1, 0), b3, voffB); PG8_STAGE(PG8_SB(1, 1), b3 + hstep, voffB); PG8_STAGE(PG8_SA(1, 0), a3, voffA);
            PG8_WAIT_V(8); PG8_WAIT_L(0); PG8_BAR; PG8_MMA(1, 0, At, B0); PG8_MMA(1, 1, At, B1); PG8_BAR; PG8_SCHED;
            } else {
            PG8_LDB(B0, 0, 0); PG8_SCHED; PG8_LDA(At, 0, 0); PG8_STAGE(PG8_SA(1, 1), a1 + hstep, voffA);
            PG8_WAIT_L(8); PG8_BAR; PG8_WAIT_L(0); PG8_MMA(0, 0, At, B0); PG8_BAR; PG8_SCHED;
            PG8_LDB(B1, 0, 1); PG8_STAGE(PG8_SB(0, 0), b2, voffB);
            PG8_BAR; PG8_WAIT_L(0); PG8_MMA(0, 1, At, B1); PG8_BAR;
            PG8_LDA(At, 0, 1); PG8_STAGE(PG8_SA(0, 0), a2, voffA);
            PG8_BAR; PG8_WAIT_L(0); PG8_MMA(1, 0, At, B0); PG8_BAR; PG8_SCHED;
            PG8_STAGE(PG8_SB(0, 1), b2 + hstep, voffB);
            PG8_WAIT_V(6); PG8_BAR; PG8_MMA(1, 1, At, B1); PG8_BAR;
            PG8_LDB(B0, 1, 0); PG8_SCHED; PG8_LDA(At, 1, 0); PG8_STAGE(PG8_SA(0, 1), a2 + hstep, voffA);
            PG8_WAIT_L(8); PG8_BAR; PG8_WAIT_L(0); PG8_MMA(0, 0, At, B0); PG8_BAR; PG8_SCHED;
            PG8_LDB(B1, 1, 1); PG8_STAGE(PG8_SB(1, 0), b3, voffB);
            PG8_BAR; PG8_WAIT_L(0); PG8_MMA(0, 1, At, B1); PG8_BAR;
            PG8_LDA(At, 1, 1); PG8_STAGE(PG8_SA(1, 0), a3, voffA);
            PG8_BAR; PG8_WAIT_L(0); PG8_MMA(1, 0, At, B0); PG8_BAR; PG8_SCHED;
            PG8_STAGE(PG8_SB(1, 1), b3 + hstep, voffB);
            PG8_WAIT_V(6); PG8_BAR; PG8_MMA(1, 1, At, B1); PG8_BAR;
            }
        }
        if constexpr (ALIGN_EPI) { if (wr == 0) PG8_BAR; }
        if constexpr (!Epi::AFTER_DRAIN) { E(acc, cur, wr, wc, fr, fq); S.done(cur); }
        if (!has_next) break;
#pragma unroll
        for (int a = 0; a < 2; ++a)
#pragma unroll
            for (int b = 0; b < 2; ++b)
#pragma unroll
                for (int m = 0; m < 4; ++m)
#pragma unroll
                    for (int n = 0; n < 2; ++n) acc[a][b][m][n] = (f32x4){0.f, 0.f, 0.f, 0.f};
        cur = nxt; cA = nA; cB = nB; ++ui;
        if constexpr (ALIGN_EPI) { if (wr == 1) PG8_BAR; }
    }
    PG8_WAIT_V(0);
    if constexpr (!ALIGN_EPI) { if (wr == 0) PG8_BAR; }
    PG8_BAR;
    if constexpr (Epi::AFTER_DRAIN) { E.fused(acc, cur, wr, wc, fr, fq, lds, wid, lane); S.done(cur); }
#undef PG8_SA
#undef PG8_SB
#undef PG8_STAGE
#undef PG8_LDA
#undef PG8_LDB
#undef PG8_MMA
#undef PG8_WAIT_V
#undef PG8_WAIT_L
#undef PG8_BAR
#undef PG8_SCHED
}
}
#define LAS __attribute__((address_space(3)))
typedef unsigned short bf16_t;
typedef short bf16x8 __attribute__((ext_vector_type(8)));
typedef float f32x4 __attribute__((ext_vector_type(4)));
typedef unsigned u32x4 __attribute__((ext_vector_type(4)));
typedef unsigned u32x2 __attribute__((ext_vector_type(2)));
using pg8::cvt_pk_bf16; using pg8::bflo; using pg8::bfhi; using pg8::bf2f; using pg8::PLD;
constexpr int DM = 2048, SEQ = 4096, NB = 4, M = NB * SEQ, INW = 9728, HID = 8192, NMOD = 6 * DM;
constexpr float EPS = 1e-6f;
constexpr size_t MiB = 1u << 20;
constexpr size_t WS_MOD = 0, WS_WIN = 1 * MiB, WS_WAB = 39 * MiB, WS_WO = 47 * MiB, WS_W1 = 55 * MiB, WS_W2 = 87 * MiB, WS_H = 120 * MiB, WS_P = 184 * MiB, WS_SSEG = 456 * MiB, WS_DSEG = 472 * MiB, WS_H2 = 440 * MiB, WS_PART = 504 * MiB, WS_END = 506 * MiB;
constexpr size_t WS_CB = 256 * 1024;
constexpr size_t WS_BAR = 512 * 1024, BAR_BYTES = 16384, WS_ROWSS = WS_BAR + BAR_BYTES, ZERO_BYTES = BAR_BYTES + 65536;
constexpr int MISC_OFF = 147456 - 64;
constexpr int LDS_BYTES = 147456;
constexpr int NTHR = 512;

__device__ __forceinline__ float wave_sum(float v) {
#pragma unroll
    for (int o = 1; o < 64; o <<= 1) v += __shfl_xor(v, o);
    return v;
}
__device__ __forceinline__ bf16x8 ldfrag(const LAS bf16_t* base, int pitch, int row, int kofs) { return *(const LAS bf16x8*)(base + row * pitch + kofs); }
#define MFMA16(a, b, c) __builtin_amdgcn_mfma_f32_16x16x32_bf16((a), (b), (c), 0, 0, 0)
#define LBAR() do { asm volatile("s_waitcnt lgkmcnt(0)" ::: "memory"); __builtin_amdgcn_s_barrier(); asm volatile("" ::: "memory"); } while (0)
#define XB_TMO      128
#define XB_XCNT(j)  (256  + 64 * (j))
#define XB_XSUB(j)  (1280 + 64 * (j))
#define XB_XGEN(j)  (2304 + 64 * (j))
#define XB_TOP      3328
#define XB_TOPGEN   3392
#define XCD_BAR_WORDS 3456
#define XB_SPIN_CAP (1u << 18)

__device__ __forceinline__ unsigned xb_ld(unsigned* p)              { return __hip_atomic_load(p, __ATOMIC_RELAXED, __HIP_MEMORY_SCOPE_AGENT); }
__device__ __forceinline__ unsigned xb_add(unsigned* p, unsigned v) { return __hip_atomic_fetch_add(p, v, __ATOMIC_RELAXED, __HIP_MEMORY_SCOPE_AGENT); }
__device__ __forceinline__ unsigned xb_xcc_id() { return (unsigned)__builtin_amdgcn_s_getreg((3 << 11) | 20) & 0xFu; }
#define XB_SPIN(cond, bar) do { unsigned _sp = 0; while (cond) { __builtin_amdgcn_s_sleep(1); \
    if ((++_sp & 255u) == 0u) { if (xb_ld(&(bar)[XB_TMO])) break; if (_sp > XB_SPIN_CAP) { atomicAdd(&(bar)[XB_TMO], 1u); break; } } } } while (0)

struct XcdBarrier {
    unsigned* bar; unsigned x;
    volatile LAS unsigned* st;
};

__device__ __forceinline__ XcdBarrier xcd_barrier_post(unsigned* bar, volatile LAS unsigned* st) {
    XcdBarrier b; b.bar = bar; b.x = xb_xcc_id(); b.st = st;
    if (threadIdx.x == 0) (void)xb_add(&bar[XB_XCNT(b.x)], 1u);
    return b;
}
__device__ __forceinline__ void xcd_barrier_complete(unsigned* bar, unsigned x, unsigned& nloc, unsigned& nx) {
    const unsigned G = gridDim.x * gridDim.y * gridDim.z;
    unsigned sum, cnt, mine, sp = 0u;
    for (;;) {
        sum = 0u; cnt = 0u; mine = 0u;
#pragma unroll
        for (unsigned j = 0; j < 16; ++j) { const unsigned c = xb_ld(&bar[XB_XCNT(j)]); sum += c; cnt += (c > 0u) ? 1u : 0u; mine = (j == x) ? c : mine; }
        if (sum == G) break;
        __builtin_amdgcn_s_sleep(1);
        if ((++sp & 255u) == 0u) { if (xb_ld(&bar[XB_TMO])) break; if (sp > XB_SPIN_CAP) { atomicAdd(&bar[XB_TMO], 1u); break; } }
    }
    nloc = mine > 0u ? mine : 1u; nx = cnt > 0u ? cnt : 1u;
}

__device__ __forceinline__ void xcd_barrier(const XcdBarrier& b) {
    asm volatile("s_waitcnt vmcnt(0)" ::: "memory");
    __syncthreads();
    if (threadIdx.x == 0) {
        unsigned* bar = b.bar;
        __builtin_amdgcn_s_waitcnt(0);
        unsigned nloc = b.st[0], nx = b.st[1];
        if (nloc == 0u) { xcd_barrier_complete(bar, b.x, nloc, nx); b.st[0] = nloc; b.st[1] = nx; }
        const unsigned old = xb_add(&bar[XB_XSUB(b.x)], 1u);
        const unsigned gen = old / nloc;
        if (old + 1u == (gen + 1u) * nloc) {
            __builtin_amdgcn_fence(__ATOMIC_RELEASE, "agent");
            asm volatile("s_waitcnt vmcnt(0)" ::: "memory");
            const unsigned og = xb_add(&bar[XB_TOP], 1u);
            const unsigned tg = og / nx;
            if (og + 1u == (tg + 1u) * nx) xb_add(&bar[XB_TOPGEN], 1u);
            else XB_SPIN(xb_ld(&bar[XB_TOPGEN]) == tg, bar);
            __builtin_amdgcn_fence(__ATOMIC_ACQUIRE, "agent");
            xb_add(&bar[XB_XGEN(b.x)], 1u);
            asm volatile("s_waitcnt vmcnt(0)" ::: "memory");
        } else {
            XB_SPIN(xb_ld(&bar[XB_XGEN(b.x)]) == gen, bar);
            __builtin_amdgcn_fence(__ATOMIC_ACQUIRE, "agent");
            asm volatile("s_waitcnt vmcnt(0)" ::: "memory");
        }
    }
    __syncthreads();
}


struct TrDesc { const float* W; bf16_t* WT; int K, N, row_off, item; };
__device__ __forceinline__ void tr_load(const TrDesc& d, int lane, f32x4 (&v)[16]) {
    const int nkb = d.K / 64, kb = d.item % nkb, nb = d.item / nkb, k0 = 64 * kb, n0 = 64 * nb;
    const float* p = d.W + (size_t)(k0 + (lane >> 4)) * d.N + n0 + 4 * (lane & 15);
#pragma unroll
    for (int i = 0; i < 16; ++i) v[i] = __builtin_nontemporal_load((const f32x4*)(p + (size_t)(4 * i) * d.N));
}
__device__ __forceinline__ void tr_store(const TrDesc& d, int lane, const f32x4 (&v)[16], LAS float* scr) {
    const int nkb = d.K / 64, kb = d.item % nkb, nb = d.item / nkb, k0 = 64 * kb, n0 = 64 * nb;
#pragma unroll
    for (int i = 0; i < 16; ++i) { LAS float* s = scr + (4 * i + (lane >> 4)) * 65 + 4 * (lane & 15); s[0] = v[i].x; s[1] = v[i].y; s[2] = v[i].z; s[3] = v[i].w; }
    __builtin_amdgcn_wave_barrier();
    const int c = lane & 7;
#pragma unroll
    for (int j = 0; j < 8; ++j) { const int n = (lane >> 3) + 8 * j; const LAS float* s = scr + (8 * c) * 65 + n;
        u32x4 o; o.x = cvt_pk_bf16(s[0 * 65], s[1 * 65]); o.y = cvt_pk_bf16(s[2 * 65], s[3 * 65]); o.z = cvt_pk_bf16(s[4 * 65], s[5 * 65]); o.w = cvt_pk_bf16(s[6 * 65], s[7 * 65]);
        *(u32x4*)(d.WT + (size_t)(d.row_off + n0 + n) * d.K + k0 + 8 * c) = o; }
    __builtin_amdgcn_wave_barrier();
}
__device__ __forceinline__ void gemv_item(const float* __restrict__ cvec, const float* __restrict__ Wada, const float* __restrict__ bada, float* mod, LAS unsigned char* lds, int item, int tid) {
    LAS f32x4* sc = (LAS f32x4*)lds;
    LAS float* red = (LAS float*)(lds + 32768);
    for (int k = tid; k < DM; k += NTHR) { f32x4 v;
#pragma unroll
        for (int b = 0; b < 4; ++b) { const float x = cvec[b * DM + k]; v[b] = x / (1.0f + __expf(-x)); }
        sc[k] = v; }
    __syncthreads();
    const int c4 = tid % 12, rl = tid / 12, n0 = item * 48;
    f32x4 a0 = {0.f, 0.f, 0.f, 0.f}, a1 = a0, a2 = a0, a3 = a0;
    if (rl < 42) {
        const float* wp = Wada + n0 + 4 * c4;
#pragma unroll 8
        for (int k = rl; k < DM; k += 42) { const f32x4 w = __builtin_nontemporal_load((const f32x4*)(wp + (size_t)k * NMOD)); const f32x4 s = sc[k]; a0 += w * s.x; a1 += w * s.y; a2 += w * s.z; a3 += w * s.w; }
        LAS f32x4* r = (LAS f32x4*)red + (rl * 12 + c4) * 4; r[0] = a0; r[1] = a1; r[2] = a2; r[3] = a3;
    }
    __syncthreads();
    if (tid < 192) { const int b = tid / 48, col = tid % 48, cc = col >> 2, e = col & 3; float s = 0.f;
        for (int r = 0; r < 42; ++r) s += red[((r * 12 + cc) * 4 + b) * 4 + e];
        mod[(size_t)b * NMOD + n0 + col] = s + bada[n0 + col]; }
    __syncthreads();
}
__device__ __forceinline__ void norm_phase(const float* X, const float* __restrict__ gain, const float* mod, int sh_off, int sc_off, bf16_t* H, int gw, int NGW, int lane) {
    for (int rg = gw; rg < M / 8; rg += NGW) {
        const int row0 = rg * 8, b = row0 >> 12;
        f32x4 gs[8], sh[8];
#pragma unroll
        for (int j = 0; j < 8; ++j) { const f32x4 g = ((const f32x4*)gain)[lane + 64 * j]; const f32x4 s = ((const f32x4*)(mod + (size_t)b * NMOD + sc_off))[lane + 64 * j];
            gs[j] = g * (s + 1.0f); sh[j] = ((const f32x4*)(mod + (size_t)b * NMOD + sh_off))[lane + 64 * j]; }
        for (int r = 0; r < 8; ++r) {
            const f32x4* xr = (const f32x4*)(X + (size_t)(row0 + r) * DM) + lane;
            f32x4 v[8]; float ss = 0.f;
#pragma unroll
            for (int j = 0; j < 8; ++j) { v[j] = __builtin_nontemporal_load(xr + 64 * j); ss += (v[j].x * v[j].x + v[j].y * v[j].y) + (v[j].z * v[j].z + v[j].w * v[j].w); }
            const float rstd = 1.0f / sqrtf(wave_sum(ss) * (1.0f / DM) + EPS);
            u32x2* o8 = (u32x2*)(H + (size_t)(row0 + r) * DM) + lane;
#pragma unroll
            for (int j = 0; j < 8; ++j) { const f32x4 y = v[j] * rstd * gs[j] + sh[j]; u32x2 w; w.x = cvt_pk_bf16(y.x, y.y); w.y = cvt_pk_bf16(y.z, y.w); o8[64 * j] = w; }
        }
    }
}
__device__ __forceinline__ void bias_phase(const bf16_t* W1T, const float* mod, float* cb, int gw, int NGW, int lane) {
    for (int n = gw; n < HID; n += NGW) {
        float w[32];
#pragma unroll
        for (int j = 0; j < 4; ++j) { const u32x4 r = *(const u32x4*)(W1T + (size_t)n * DM + (j * 64 + lane) * 8);
            w[8 * j + 0] = bflo(r.x); w[8 * j + 1] = bfhi(r.x); w[8 * j + 2] = bflo(r.y); w[8 * j + 3] = bfhi(r.y); w[8 * j + 4] = bflo(r.z); w[8 * j + 5] = bfhi(r.z); w[8 * j + 6] = bflo(r.w); w[8 * j + 7] = bfhi(r.w); }
#pragma unroll
        for (int b = 0; b < 4; ++b) { const float* sh = mod + (size_t)b * NMOD + 3 * DM; float s = 0.f;
#pragma unroll
            for (int j = 0; j < 4; ++j) { const f32x4 s0 = *(const f32x4*)(sh + (j * 64 + lane) * 8), s1 = *(const f32x4*)(sh + (j * 64 + lane) * 8 + 4);
                s += (w[8 * j + 0] * s0.x + w[8 * j + 1] * s0.y) + (w[8 * j + 2] * s0.z + w[8 * j + 3] * s0.w) + (w[8 * j + 4] * s1.x + w[8 * j + 5] * s1.y) + (w[8 * j + 6] * s1.z + w[8 * j + 7] * s1.w); }
            s = wave_sum(s);
            if (lane == 0) cb[(size_t)b * HID + n] = s; }
    }
}
typedef float f32x2 __attribute__((ext_vector_type(2)));
typedef short v4i16_t __attribute__((ext_vector_type(4)));
template <bool FULL>
__device__ __forceinline__ void hgrn_seg(int b, int h, int sg, const bf16_t* P, const float* LOGF, const float* __restrict__ ogain, bf16_t* OA, float* SSEG, float* DSEG, LAS unsigned char* lds, int tid) {
    const int lane = tid & 63, wid = __builtin_amdgcn_readfirstlane(tid >> 6), fr = lane & 15, fq = lane >> 4;
    LAS bf16_t* Qd = (LAS bf16_t*)lds;
    LAS bf16_t* Kd = Qd + 64 * 136;
    LAS bf16_t* Qb = Kd + 64 * 136;
    LAS bf16_t* KlT = Qb + 64 * 136;
    LAS bf16_t* VT = KlT + 128 * 72;
    LAS bf16_t* Pm = VT + 128 * 72;
    LAS bf16_t* ST = Pm + 64 * 72;
    LAS float* segtot = (LAS float*)(ST + 128 * 136);
    LAS float* dec = segtot + 1024;
    LAS float* rsq = dec + 128;
    const int unit = (b * 8 + h) * 8 + sg;
    f32x4 sacc[8];
#pragma unroll
    for (int kt = 0; kt < 8; ++kt) sacc[kt] = (f32x4){0.f, 0.f, 0.f, 0.f};
    const int kp = lane, t0 = wid * 8;
    const int tt = wid & 3, vh = wid >> 2;
    f32x4 gn[4];
    if (FULL) {
        for (int j = 0; j < sg; ++j) { const int uj = unit - sg + j;
#pragma unroll
            for (int kt = 0; kt < 8; ++kt) { const f32x4 d = *(const f32x4*)(DSEG + (size_t)uj * 128 + kt * 16 + 4 * fq); const f32x4 sv = *(const f32x4*)(SSEG + ((size_t)uj * 8 + kt) * 2048 + tid * 4); sacc[kt] = sacc[kt] * d + sv; } }
#pragma unroll
        for (int kt = 0; kt < 8; ++kt) { u32x2 w; w.x = cvt_pk_bf16(sacc[kt][0], sacc[kt][1]); w.y = cvt_pk_bf16(sacc[kt][2], sacc[kt][3]);
            *(LAS u32x2*)(ST + (wid * 16 + fr) * 136 + kt * 16 + 4 * fq) = w; }
#pragma unroll
        for (int vt = 0; vt < 4; ++vt) gn[vt] = *(const f32x4*)(ogain + h * 128 + (vh * 4 + vt) * 16 + 4 * fq);
    }
    f32x2 dsum = {0.f, 0.f};
    f32x2 lf[8]; unsigned qv[8], vv[8];
    {   const size_t r0 = (size_t)b * SEQ + (size_t)(sg * 8) * 64;
#pragma unroll
        for (int j = 0; j < 8; ++j) { const size_t row = r0 + t0 + j; lf[j] = __builtin_nontemporal_load((const f32x2*)(LOGF + row * 1024 + h * 128 + 2 * kp)); vv[j] = __builtin_nontemporal_load((const unsigned*)(P + row * PLD + 1024 + h * 128 + 2 * kp)); if (FULL) qv[j] = __builtin_nontemporal_load((const unsigned*)(P + row * PLD + h * 128 + 2 * kp)); } }
    LBAR();
    for (int n = 0; n < 8; ++n) {
        const size_t r0 = (size_t)b * SEQ + (size_t)(sg * 8 + n) * 64;
        f32x2 cs[8];
        { f32x2 a = {0.f, 0.f};
#pragma unroll
          for (int j = 0; j < 8; ++j) { a += lf[j]; cs[j] = a; } }
        *(LAS f32x2*)(segtot + wid * 128 + 2 * kp) = cs[7];
        u32x2 gg[4];
        if (FULL) {
#pragma unroll
            for (int vt = 0; vt < 4; ++vt) gg[vt] = *(const u32x2*)(P + (r0 + tt * 16 + fr) * PLD + 2048 + h * 128 + (vh * 4 + vt) * 16 + 4 * fq);
        }
        LBAR();
        f32x2 off = {0.f, 0.f}, bmid = {0.f, 0.f}, blast = {0.f, 0.f};
#pragma unroll
        for (int s8 = 0; s8 < 8; ++s8) { const f32x2 tv = *(const LAS f32x2*)(segtot + s8 * 128 + 2 * kp); if (s8 < wid) off += tv; if (s8 < 4) bmid += tv; blast += tv; }
        dsum += blast;
        f32x2 emid, elm;
        emid.x = __expf(bmid.x); emid.y = __expf(bmid.y); elm.x = __expf(blast.x - bmid.x); elm.y = __expf(blast.y - bmid.y);
        float kl0[8], kl1[8];
#pragma unroll
        for (int j = 0; j < 8; ++j) { const f32x2 bb = cs[j] + off;
            const float f0 = __expf(lf[j].x), f1 = __expf(lf[j].y), kk0 = 1.0f - f0, kk1 = 1.0f - f1;
            const float e0 = __expf(bb.x - bmid.x), e1 = __expf(bb.y - bmid.y), i0 = __expf(bmid.x - bb.x), i1 = __expf(bmid.y - bb.y);
            if (FULL) { const float q0 = bflo(qv[j]), q1 = bfhi(qv[j]);
                *(LAS unsigned*)(Qd + (t0 + j) * 136 + 2 * kp) = cvt_pk_bf16(q0 * e0, q1 * e1);
                *(LAS unsigned*)(Kd + (t0 + j) * 136 + 2 * kp) = cvt_pk_bf16(kk0 * i0, kk1 * i1);
                *(LAS unsigned*)(Qb + (t0 + j) * 136 + 2 * kp) = cvt_pk_bf16(q0 * e0 * emid.x, q1 * e1 * emid.y); }
            kl0[j] = kk0 * i0 * elm.x; kl1[j] = kk1 * i1 * elm.y; }
        { u32x4 w0, w1; w0.x = cvt_pk_bf16(kl0[0], kl0[1]); w0.y = cvt_pk_bf16(kl0[2], kl0[3]); w0.z = cvt_pk_bf16(kl0[4], kl0[5]); w0.w = cvt_pk_bf16(kl0[6], kl0[7]);
          w1.x = cvt_pk_bf16(kl1[0], kl1[1]); w1.y = cvt_pk_bf16(kl1[2], kl1[3]); w1.z = cvt_pk_bf16(kl1[4], kl1[5]); w1.w = cvt_pk_bf16(kl1[6], kl1[7]);
          *(LAS u32x4*)(KlT + (2 * kp) * 72 + t0) = w0; *(LAS u32x4*)(KlT + (2 * kp + 1) * 72 + t0) = w1;
          u32x4 v0, v1;
          v0.x = (vv[0] & 0xffffu) | (vv[1] << 16); v0.y = (vv[2] & 0xffffu) | (vv[3] << 16); v0.z = (vv[4] & 0xffffu) | (vv[5] << 16); v0.w = (vv[6] & 0xffffu) | (vv[7] << 16);
          v1.x = (vv[0] >> 16) | (vv[1] & 0xffff0000u); v1.y = (vv[2] >> 16) | (vv[3] & 0xffff0000u); v1.z = (vv[4] >> 16) | (vv[5] & 0xffff0000u); v1.w = (vv[6] >> 16) | (vv[7] & 0xffff0000u);
          *(LAS u32x4*)(VT + (2 * kp) * 72 + t0) = v0; *(LAS u32x4*)(VT + (2 * kp + 1) * 72 + t0) = v1; }
        if (wid == 0) { f32x2 dv; dv.x = __expf(blast.x); dv.y = __expf(blast.y); *(LAS f32x2*)(dec + 2 * kp) = dv; }
        if (n + 1 < 8) {
            const size_t r1 = r0 + 64;
#pragma unroll
            for (int j = 0; j < 8; ++j) { const size_t row = r1 + t0 + j; lf[j] = __builtin_nontemporal_load((const f32x2*)(LOGF + row * 1024 + h * 128 + 2 * kp)); vv[j] = __builtin_nontemporal_load((const unsigned*)(P + row * PLD + 1024 + h * 128 + 2 * kp)); if (FULL) qv[j] = __builtin_nontemporal_load((const unsigned*)(P + row * PLD + h * 128 + 2 * kp)); }
        }
        LBAR();
        f32x4 o[4];
        if (FULL) {
#pragma unroll
            for (int q = 0; q < 2; ++q) { const int id = wid * 2 + q, t2 = id >> 2, st = id & 3;
                f32x4 acc = {0.f, 0.f, 0.f, 0.f};
                if (st <= t2) {
#pragma unroll
                    for (int ks = 0; ks < 4; ++ks) acc = MFMA16(ldfrag(Kd, 136, st * 16 + fr, ks * 32 + 8 * fq), ldfrag(Qd, 136, t2 * 16 + fr, ks * 32 + 8 * fq), acc);
                }
                const int t = t2 * 16 + fr, s0 = st * 16 + 4 * fq;
                u32x2 w; w.x = cvt_pk_bf16(s0 + 0 <= t ? acc[0] : 0.f, s0 + 1 <= t ? acc[1] : 0.f); w.y = cvt_pk_bf16(s0 + 2 <= t ? acc[2] : 0.f, s0 + 3 <= t ? acc[3] : 0.f);
                *(LAS u32x2*)(Pm + t * 72 + s0) = w; }
            LBAR();
            float ss = 0.f;
#pragma unroll
            for (int vt = 0; vt < 4; ++vt) { const int vrow = (vh * 4 + vt) * 16 + fr; f32x4 acc = {0.f, 0.f, 0.f, 0.f};
#pragma unroll
                for (int ks = 0; ks < 2; ++ks) acc = MFMA16(ldfrag(VT, 72, vrow, ks * 32 + 8 * fq), ldfrag(Pm, 72, tt * 16 + fr, ks * 32 + 8 * fq), acc);
#pragma unroll
                for (int ks = 0; ks < 4; ++ks) acc = MFMA16(ldfrag(ST, 136, vrow, ks * 32 + 8 * fq), ldfrag(Qb, 136, tt * 16 + fr, ks * 32 + 8 * fq), acc);
                o[vt] = acc; ss += (acc[0] * acc[0] + acc[1] * acc[1]) + (acc[2] * acc[2] + acc[3] * acc[3]); }
            ss += __shfl_xor(ss, 16); ss += __shfl_xor(ss, 32);
            if (fq == 0) rsq[vh * 64 + tt * 16 + fr] = ss;
        }
#pragma unroll
        for (int kt = 0; kt < 8; ++kt) { const f32x4 d = *(const LAS f32x4*)(dec + kt * 16 + 4 * fq); f32x4 acc = sacc[kt] * d;
#pragma unroll
            for (int ks = 0; ks < 2; ++ks) acc = MFMA16(ldfrag(KlT, 72, kt * 16 + fr, ks * 32 + 8 * fq), ldfrag(VT, 72, wid * 16 + fr, ks * 32 + 8 * fq), acc);
            sacc[kt] = acc; }
        LBAR();
        if (FULL) {
            { const int t = tt * 16 + fr; const float rstd = 1.0f / sqrtf((rsq[t] + rsq[64 + t]) * (1.0f / 128.0f) + EPS); const size_t row = r0 + t;
#pragma unroll
              for (int vt = 0; vt < 4; ++vt) { const int v0 = h * 128 + (vh * 4 + vt) * 16 + 4 * fq; const u32x2 g = gg[vt];
                  u32x2 w; w.x = cvt_pk_bf16(o[vt][0] * rstd * gn[vt].x * bflo(g.x), o[vt][1] * rstd * gn[vt].y * bfhi(g.x)); w.y = cvt_pk_bf16(o[vt][2] * rstd * gn[vt].z * bflo(g.y), o[vt][3] * rstd * gn[vt].w * bfhi(g.y));
                  *(u32x2*)(OA + row * 1024 + v0) = w; } }
            if (n + 1 < 8) {
#pragma unroll
                for (int kt = 0; kt < 8; ++kt) { u32x2 w; w.x = cvt_pk_bf16(sacc[kt][0], sacc[kt][1]); w.y = cvt_pk_bf16(sacc[kt][2], sacc[kt][3]);
                    *(LAS u32x2*)(ST + (wid * 16 + fr) * 136 + kt * 16 + 4 * fq) = w; }
            }
        }
    }
    if (!FULL) {
#pragma unroll
        for (int kt = 0; kt < 8; ++kt) *(f32x4*)(SSEG + ((size_t)unit * 8 + kt) * 2048 + tid * 4) = sacc[kt];
        if (wid == 0) { f32x2 dv; dv.x = __expf(dsum.x); dv.y = __expf(dsum.y); *(f32x2*)(DSEG + (size_t)unit * 128 + 2 * kp) = dv; }
    }
    LBAR();
}
__device__ __forceinline__ void hgrn_state(int b, int h, int sg, const bf16_t* P, const float* LOGF, float* SSEG, float* DSEG, LAS unsigned char* lds, int tid) {
    const int lane = tid & 63, wid = __builtin_amdgcn_readfirstlane(tid >> 6), fr = lane & 15, fq = lane >> 4;
    LAS bf16_t* KlT = (LAS bf16_t*)lds;
    LAS bf16_t* VT = KlT + 128 * 136;
    LAS float* segtot = (LAS float*)(VT + 128 * 136);
    const int unit = (b * 8 + h) * 8 + sg, kp = lane, t0 = wid * 16;
    f32x4 sacc[8];
#pragma unroll
    for (int kt = 0; kt < 8; ++kt) sacc[kt] = (f32x4){0.f, 0.f, 0.f, 0.f};
    f32x2 carry = {0.f, 0.f};
    f32x2 lf[16]; unsigned vv[16];
    const size_t rseg = (size_t)b * SEQ + (size_t)sg * 512;
#pragma unroll
    for (int j = 0; j < 16; ++j) { const size_t row = rseg + 384 + t0 + j; lf[j] = *(const f32x2*)(LOGF + row * 1024 + h * 128 + 2 * kp); vv[j] = *(const unsigned*)(P + row * PLD + 1024 + h * 128 + 2 * kp); }
    for (int sb = 3; sb >= 0; --sb) {
        f32x2 suf[16];
        { f32x2 a = {0.f, 0.f};
#pragma unroll
          for (int j = 15; j >= 0; --j) { suf[j] = a; a += lf[j]; }
          *(LAS f32x2*)(segtot + wid * 128 + 2 * kp) = a; }
        LBAR();
        f32x2 after = carry, sub = {0.f, 0.f};
#pragma unroll
        for (int w = 0; w < 8; ++w) { const f32x2 tv = *(const LAS f32x2*)(segtot + w * 128 + 2 * kp); if (w > wid) after += tv; sub += tv; }
        carry += sub;
        float kl0[16], kl1[16];
#pragma unroll
        for (int j = 0; j < 16; ++j) { const f32x2 e = suf[j] + after; kl0[j] = (1.0f - __expf(lf[j].x)) * __expf(e.x); kl1[j] = (1.0f - __expf(lf[j].y)) * __expf(e.y); }
#pragma unroll
        for (int q = 0; q < 2; ++q) { u32x4 w0, w1, v0, v1;
            w0.x = cvt_pk_bf16(kl0[8 * q + 0], kl0[8 * q + 1]); w0.y = cvt_pk_bf16(kl0[8 * q + 2], kl0[8 * q + 3]); w0.z = cvt_pk_bf16(kl0[8 * q + 4], kl0[8 * q + 5]); w0.w = cvt_pk_bf16(kl0[8 * q + 6], kl0[8 * q + 7]);
            w1.x = cvt_pk_bf16(kl1[8 * q + 0], kl1[8 * q + 1]); w1.y = cvt_pk_bf16(kl1[8 * q + 2], kl1[8 * q + 3]); w1.z = cvt_pk_bf16(kl1[8 * q + 4], kl1[8 * q + 5]); w1.w = cvt_pk_bf16(kl1[8 * q + 6], kl1[8 * q + 7]);
            *(LAS u32x4*)(KlT + (2 * kp) * 136 + t0 + 8 * q) = w0; *(LAS u32x4*)(KlT + (2 * kp + 1) * 136 + t0 + 8 * q) = w1;
            v0.x = (vv[8 * q + 0] & 0xffffu) | (vv[8 * q + 1] << 16); v0.y = (vv[8 * q + 2] & 0xffffu) | (vv[8 * q + 3] << 16); v0.z = (vv[8 * q + 4] & 0xffffu) | (vv[8 * q + 5] << 16); v0.w = (vv[8 * q + 6] & 0xffffu) | (vv[8 * q + 7] << 16);
            v1.x = (vv[8 * q + 0] >> 16) | (vv[8 * q + 1] & 0xffff0000u); v1.y = (vv[8 * q + 2] >> 16) | (vv[8 * q + 3] & 0xffff0000u); v1.z = (vv[8 * q + 4] >> 16) | (vv[8 * q + 5] & 0xffff0000u); v1.w = (vv[8 * q + 6] >> 16) | (vv[8 * q + 7] & 0xffff0000u);
            *(LAS u32x4*)(VT + (2 * kp) * 136 + t0 + 8 * q) = v0; *(LAS u32x4*)(VT + (2 * kp + 1) * 136 + t0 + 8 * q) = v1; }
        if (sb > 0) {
#pragma unroll
            for (int j = 0; j < 16; ++j) { const size_t row = rseg + (size_t)(sb - 1) * 128 + t0 + j; lf[j] = *(const f32x2*)(LOGF + row * 1024 + h * 128 + 2 * kp); vv[j] = *(const unsigned*)(P + row * PLD + 1024 + h * 128 + 2 * kp); }
        }
        LBAR();
        bf16x8 vf[4];
#pragma unroll
        for (int ks = 0; ks < 4; ++ks) vf[ks] = ldfrag(VT, 136, wid * 16 + fr, ks * 32 + 8 * fq);
#pragma unroll
        for (int kt = 0; kt < 8; ++kt) { f32x4 acc = sacc[kt];
#pragma unroll
            for (int ks = 0; ks < 4; ++ks) acc = MFMA16(ldfrag(KlT, 136, kt * 16 + fr, ks * 32 + 8 * fq), vf[ks], acc);
            sacc[kt] = acc; }
        LBAR();
    }
#pragma unroll
    for (int kt = 0; kt < 8; ++kt) *(f32x4*)(SSEG + ((size_t)unit * 8 + kt) * 2048 + tid * 4) = sacc[kt];
    if (wid == 0) { f32x2 dv; dv.x = __expf(carry.x); dv.y = __expf(carry.y); *(f32x2*)(DSEG + (size_t)unit * 128 + 2 * kp) = dv; }
}
struct SwaRaw { u32x4 k[4], v[4], q[2]; };
__device__ __forceinline__ void swa_load(SwaRaw& R, int b, int kvh, int nb, const bf16_t* P, int tid) {
    const size_t rq0 = (size_t)b * SEQ + (size_t)nb * 128; const int ch = tid & 7;
#pragma unroll
    for (int p = 0; p < 4; ++p) { const int ki = (tid >> 3) + 64 * p; const bool valid = (nb > 0) || (ki >= 128);
        R.k[p] = (u32x4){0u, 0u, 0u, 0u}; R.v[p] = (u32x4){0u, 0u, 0u, 0u};
        if (valid) { const size_t row = rq0 - 128 + ki; R.k[p] = *(const u32x4*)(P + row * PLD + 4096 + kvh * 64 + ch * 8); R.v[p] = *(const u32x4*)(P + row * PLD + 4352 + kvh * 64 + ch * 8); } }
#pragma unroll
    for (int p = 0; p < 2; ++p) R.q[p] = *(const u32x4*)(P + (rq0 + (tid >> 3) + 64 * p) * PLD + 3072 + (kvh * 4) * 64 + ch * 8);
}
__device__ __forceinline__ void swa_compute(SwaRaw& R, int b, int kvh, int nb, const bf16_t* P, const float* __restrict__ qg, const float* __restrict__ kg, const float* __restrict__ sinks, bf16_t* OB, LAS unsigned char* lds, int tid) {
    const int lane = tid & 63, wid = __builtin_amdgcn_readfirstlane(tid >> 6), fr = lane & 15, fq = lane >> 4;
    LAS bf16_t* Qs = (LAS bf16_t*)lds;
    LAS bf16_t* Ks = Qs + 128 * 72;
    LAS bf16_t* Vr = Ks + 256 * 72;
    LAS bf16_t* Pw = Vr + 256 * 72 + wid * (16 * 168);
    const size_t rq0 = (size_t)b * SEQ + (size_t)nb * 128;
    const int ch = tid & 7;
    {
        const f32x4 g0 = *(const f32x4*)(kg + ch * 8), g1 = *(const f32x4*)(kg + ch * 8 + 4);
#pragma unroll
        for (int p = 0; p < 4; ++p) { const int ki = (tid >> 3) + 64 * p; const u32x4 raw = R.k[p], rv = R.v[p];
            float x[8] = {bflo(raw.x), bfhi(raw.x), bflo(raw.y), bfhi(raw.y), bflo(raw.z), bfhi(raw.z), bflo(raw.w), bfhi(raw.w)};
            float ss = 0.f;
#pragma unroll
            for (int e = 0; e < 8; ++e) ss += x[e] * x[e];
            ss += __shfl_xor(ss, 1); ss += __shfl_xor(ss, 2); ss += __shfl_xor(ss, 4);
            const float rs = 1.0f / sqrtf(ss * (1.0f / 64.0f) + EPS);
            u32x4 w; w.x = cvt_pk_bf16(x[0] * rs * g0.x, x[1] * rs * g0.y); w.y = cvt_pk_bf16(x[2] * rs * g0.z, x[3] * rs * g0.w); w.z = cvt_pk_bf16(x[4] * rs * g1.x, x[5] * rs * g1.y); w.w = cvt_pk_bf16(x[6] * rs * g1.z, x[7] * rs * g1.w);
            *(LAS u32x4*)(Ks + ki * 72 + ch * 8) = w;
            *(LAS u32x4*)(Vr + ki * 72 + ch * 8) = rv; }
    }
    const f32x4 qg0 = *(const f32x4*)(qg + ch * 8), qg1 = *(const f32x4*)(qg + ch * 8 + 4);
    const int kt0 = wid > 0 ? wid - 1 : 0;
    for (int g = 0; g < 4; ++g) {
        const int hq = kvh * 4 + g;
#pragma unroll
        for (int p = 0; p < 2; ++p) { const int row = (tid >> 3) + 64 * p; const u32x4 raw = R.q[p];
            float x[8] = {bflo(raw.x), bfhi(raw.x), bflo(raw.y), bfhi(raw.y), bflo(raw.z), bfhi(raw.z), bflo(raw.w), bfhi(raw.w)};
            float ss = 0.f;
#pragma unroll
            for (int e = 0; e < 8; ++e) ss += x[e] * x[e];
            ss += __shfl_xor(ss, 1); ss += __shfl_xor(ss, 2); ss += __shfl_xor(ss, 4);
            const float rs = 0.125f / sqrtf(ss * (1.0f / 64.0f) + EPS);
            u32x4 w; w.x = cvt_pk_bf16(x[0] * rs * qg0.x, x[1] * rs * qg0.y); w.y = cvt_pk_bf16(x[2] * rs * qg0.z, x[3] * rs * qg0.w); w.z = cvt_pk_bf16(x[4] * rs * qg1.x, x[5] * rs * qg1.y); w.w = cvt_pk_bf16(x[6] * rs * qg1.z, x[7] * rs * qg1.w);
            *(LAS u32x4*)(Qs + row * 72 + ch * 8) = w; }
        if (g < 3) {
#pragma unroll
            for (int p = 0; p < 2; ++p) R.q[p] = *(const u32x4*)(P + (rq0 + (tid >> 3) + 64 * p) * PLD + 3072 + (hq + 1) * 64 + ch * 8);
        }
        LBAR();
        f32x4 s[10];
#pragma unroll
        for (int j = 0; j < 10; ++j) { f32x4 acc = {0.f, 0.f, 0.f, 0.f};
#pragma unroll
            for (int ks = 0; ks < 2; ++ks) acc = MFMA16(ldfrag(Ks, 72, (kt0 + j) * 16 + fr, ks * 32 + 8 * fq), ldfrag(Qs, 72, wid * 16 + fr, ks * 32 + 8 * fq), acc);
            s[j] = acc; }
        const int qi = wid * 16 + fr; const float sink = sinks[hq]; float m = sink;
#pragma unroll
        for (int j = 0; j < 10; ++j)
#pragma unroll
            for (int r = 0; r < 4; ++r) { const int ki = (kt0 + j) * 16 + 4 * fq + r; const bool valid = (ki > qi) && (ki <= qi + 128) && ((nb > 0) || (ki >= 128));
                s[j][r] = valid ? s[j][r] : -INFINITY; m = fmaxf(m, s[j][r]); }
        m = fmaxf(m, __shfl_xor(m, 16)); m = fmaxf(m, __shfl_xor(m, 32));
        float sum = 0.f;
#pragma unroll
        for (int j = 0; j < 10; ++j) {
#pragma unroll
            for (int r = 0; r < 4; ++r) { s[j][r] = __expf(s[j][r] - m); sum += s[j][r]; }
            u32x2 w; w.x = cvt_pk_bf16(s[j][0], s[j][1]); w.y = cvt_pk_bf16(s[j][2], s[j][3]);
            *(LAS u32x2*)(Pw + fr * 168 + j * 16 + 4 * fq) = w; }
        sum += __shfl_xor(sum, 16); sum += __shfl_xor(sum, 32);
        const float inv = 1.0f / (sum + __expf(sink - m));
        asm volatile("s_waitcnt lgkmcnt(0)" ::: "memory"); __builtin_amdgcn_wave_barrier();
#pragma unroll
        for (int dt = 0; dt < 4; ++dt) { f32x4 acc = {0.f, 0.f, 0.f, 0.f};
#pragma unroll
            for (int ks = 0; ks < 5; ++ks) { const LAS bf16_t* vp = Vr + (kt0 * 16 + ks * 32 + 8 * fq + (fr >> 2)) * 72 + dt * 16 + 4 * (fr & 3);
                const v4i16_t lo = __builtin_amdgcn_ds_read_tr16_b64_v4i16((LAS v4i16_t*)vp), hi = __builtin_amdgcn_ds_read_tr16_b64_v4i16((LAS v4i16_t*)(vp + 4 * 72));
                const bf16x8 vf = {lo[0], lo[1], lo[2], lo[3], hi[0], hi[1], hi[2], hi[3]};
                acc = MFMA16(vf, ldfrag(Pw, 168, fr, ks * 32 + 8 * fq), acc); }
            u32x2 w; w.x = cvt_pk_bf16(acc[0] * inv, acc[1] * inv); w.y = cvt_pk_bf16(acc[2] * inv, acc[3] * inv);
            *(u32x2*)(OB + (rq0 + qi) * 1024 + hq * 64 + dt * 16 + 4 * fq) = w; }
        LBAR();
    }
}

struct Args { const float* in[17]; float* out; unsigned char* ws; };
__global__ void __launch_bounds__(NTHR, 2) fwd_megakernel(Args a) {
    extern __shared__ __attribute__((aligned(16))) unsigned char lds_raw[];
    cg::grid_group grid = cg::this_grid();
    LAS unsigned char* lds = (LAS unsigned char*)lds_raw;
    const int tid = threadIdx.x, lane = tid & 63, wave = __builtin_amdgcn_readfirstlane(tid >> 6);
    const int G = gridDim.x, blk = blockIdx.x;
    const int vcu = (G % 8 == 0) ? (blk % 8) * (G / 8) + blk / 8 : blk;
    const int gw = vcu * 8 + wave, NGW = G * 8;
    const float *x = a.in[0], *cvec = a.in[1], *w_ada = a.in[2], *b_ada = a.in[3], *g1 = a.in[4], *w_in = a.in[5], *lbl = a.in[6], *ogain = a.in[7], *qg = a.in[8], *kg = a.in[9], *sinks = a.in[10],
                *w_a = a.in[11], *w_b = a.in[12], *w_o = a.in[13], *g2 = a.in[14], *w1 = a.in[15], *w2 = a.in[16];
    unsigned char* ws = a.ws;
    float* mod = (float*)(ws + WS_MOD);
    bf16_t *WinT = (bf16_t*)(ws + WS_WIN), *WabT = (bf16_t*)(ws + WS_WAB), *WoT = (bf16_t*)(ws + WS_WO), *W1T = (bf16_t*)(ws + WS_W1), *W2T = (bf16_t*)(ws + WS_W2);
    bf16_t *H = (bf16_t*)(ws + WS_H), *P = (bf16_t*)(ws + WS_P), *U = (bf16_t*)(ws + WS_P);
    float* out = a.out;
    float* LOGF = out;
    bf16_t* OAB = (bf16_t*)(out + (size_t)M * 1024);
    float* SSEG = (float*)(ws + WS_SSEG); float* DSEG = (float*)(ws + WS_DSEG);
    bf16_t* H2 = (bf16_t*)(ws + WS_H2); float* cb = (float*)(ws + WS_CB); float* part = (float*)(ws + WS_PART);
    volatile LAS unsigned* MISC = (volatile LAS unsigned*)(lds + MISC_OFF);
    if (tid < 16) MISC[tid] = 0u;
    __syncthreads();
    XcdBarrier bar = xcd_barrier_post((unsigned*)(ws + WS_BAR), MISC + 8);
#define GRID_SYNC() xcd_barrier(bar)
    if (a.ws == nullptr) grid.sync();

    for (int it = blk; it < NMOD / 48; it += G) gemv_item(cvec, w_ada, b_ada, mod, lds, it, tid);
    LAS float* scr = (LAS float*)(lds + wave * 16640);
    constexpr int I_IN = (DM / 64) * (INW / 64), I_A = (1024 / 64) * (DM / 64), I_O = (DM / 64) * (DM / 64), I_1 = (DM / 64) * (HID / 64), I_2 = (HID / 64) * (DM / 64);
    constexpr int NP0 = I_IN + 2 * I_A + I_O, NITEMS = NP0 + I_1 + I_2;
    {
#define TR_DECODE(it_, d_) do { int r_ = (it_); \
            if (r_ < I_IN) { d_ = TrDesc{w_in, WinT, DM, INW, 0, r_}; break; } r_ -= I_IN; \
            if (r_ < I_A) { d_ = TrDesc{w_b, WabT, 1024, DM, 0, r_}; break; } r_ -= I_A; \
            if (r_ < I_A) { d_ = TrDesc{w_a, WabT, 1024, DM, DM, r_}; break; } r_ -= I_A; \
            if (r_ < I_O) { d_ = TrDesc{w_o, WoT, DM, DM, 0, r_}; break; } r_ -= I_O; \
            if (r_ < I_1) { d_ = TrDesc{w1, W1T, DM, HID, 0, r_}; break; } r_ -= I_1; \
            d_ = TrDesc{w2, W2T, HID, DM, 0, r_}; } while (0)
#define TR_RUN(first_, stride_, hi_) do { int it = (first_); \
        if (it < (hi_)) { f32x4 va[16], vb[16]; TrDesc da, db; TR_DECODE(it, da); tr_load(da, lane, va); \
            for (;;) { const int it2 = it + (stride_); const bool h2 = it2 < (hi_); \
                if (h2) { TR_DECODE(it2, db); tr_load(db, lane, vb); } \
                tr_store(da, lane, va, scr); if (!h2) break; \
                const int it3 = it2 + (stride_); const bool h3 = it3 < (hi_); \
                if (h3) { TR_DECODE(it3, da); tr_load(da, lane, va); } \
                tr_store(db, lane, vb, scr); if (!h3) break; it = it3; } } } while (0)
        TR_RUN(gw, NGW, NP0);
    }
    GRID_SYNC();
    norm_phase(x, g1, mod, 0, DM, H, gw, NGW, lane);
    GRID_SYNC();
    {
        pg8::Gemm g{H, WinT, M, INW, DM}; pg8::InOrder S; S.base.init(M, INW, G, blk);
        pg8::EpiIn E{P, LOGF, lbl};
        pg8::gemm_phase<pg8::EpiIn, pg8::InOrder, true, true>(lds, g, S, E);
    }
    {
        constexpr int nwg = (M / 256) * (INW / 256);
        const int maxu = (nwg + G - 1) / G, first_idle = nwg - (maxu - 1) * G, n_idle = first_idle < G ? G - first_idle : 0;
        if (n_idle > 0) { if (blk >= first_idle) TR_RUN(NP0 + (blk - first_idle) * 8 + wave, n_idle * 8, NITEMS); }
        else TR_RUN(NP0 + gw, NGW, NITEMS);
    }
    GRID_SYNC();
    for (int u = blk; u < 256; u += G) { SwaRaw R; swa_load(R, u >> 7, (u >> 5) & 3, u & 31, P, tid);
        hgrn_state(u >> 6, (u >> 3) & 7, u & 7, P, LOGF, SSEG, DSEG, lds, tid);
        swa_compute(R, u >> 7, (u >> 5) & 3, u & 31, P, qg, kg, sinks, OAB, lds, tid); }
    if (G == 256) bias_phase(W1T, mod, cb, gw, NGW, lane);
    GRID_SYNC();
    for (int u = blk; u < 256; u += G) { const int us = 256 + u;
        hgrn_seg<true>(u >> 6, (u >> 3) & 7, u & 7, P, LOGF, ogain, OAB + (size_t)M * 1024, SSEG, DSEG, lds, tid);
        SwaRaw R; swa_load(R, us >> 7, (us >> 5) & 3, us & 31, P, tid);
        swa_compute(R, us >> 7, (us >> 5) & 3, us & 31, P, qg, kg, sinks, OAB, lds, tid); }
    GRID_SYNC();
    {
        pg8::Gemm g{OAB, WabT, 2 * M, 2 * DM, 1024}; pg8::PairOrder S; S.base.init(M, DM, G, blk);
        pg8::EpiMerge E{P, H};
        pg8::gemm_phase<pg8::EpiMerge, pg8::PairOrder, true, true>(lds, g, S, E);
    }
    GRID_SYNC();
    if (G == 256) {
    {
        pg8::Gemm g{H, WoT, M, DM, DM}; pg8::StaticOrderW<4> S; S.init(M, DM, G, blk);
        pg8::EpiRes3 E{x, out, mod, g2, H2, part};
        pg8::gemm_phase<pg8::EpiRes3, pg8::StaticOrderW<4>, true, true>(lds, g, S, E);
    }
    GRID_SYNC();
    {
        pg8::Gemm g{H2, W1T, M, HID, DM}; pg8::StaticOrderW<4> S; S.init(M, HID, G, blk);
        pg8::Unit u0; S.next(0, u0);
        LAS float* rstd = (LAS float*)(lds + 131072 + 1024);
        { const int row = ((u0.pm & ~4) | ((tid >> 8) << 2)) * 256 + (tid & 255); float sacc = 0.f;
#pragma unroll 8
          for (int j = 0; j < 32; ++j) sacc += part[(size_t)j * 16384 + row];
          rstd[tid] = 1.0f / sqrtf(sacc * (1.0f / DM) + EPS); }
        __syncthreads();
        pg8::EpiUp2 E{U, HID, rstd, cb};
        pg8::gemm_phase<pg8::EpiUp2, pg8::StaticOrderW<4>, true, true>(lds, g, S, E);
    }
    GRID_SYNC();
    } else {
    {
        pg8::Gemm g{H, WoT, M, DM, DM}; pg8::StaticOrder S; S.init(M, DM, G, blk);
        pg8::EpiRes E{x, out, mod + 2 * DM};
        pg8::gemm_phase<pg8::EpiRes, pg8::StaticOrder, true, true>(lds, g, S, E);
    }
    GRID_SYNC();
    norm_phase(out, g2, mod, 3 * DM, 4 * DM, H, gw, NGW, lane);
    GRID_SYNC();
    {
        pg8::Gemm g{H, W1T, M, HID, DM}; pg8::StaticOrder S; S.init(M, HID, G, blk);
        pg8::EpiRelu2 E{U, HID};
        pg8::gemm_phase<pg8::EpiRelu2, pg8::StaticOrder, true, true>(lds, g, S, E);
    }
    GRID_SYNC();
    }
    {
        pg8::Gemm g{U, W2T, M, DM, HID}; pg8::StaticOrderW<4> S; S.init(M, DM, G, blk);
        pg8::EpiRes E{out, out, mod + 5 * DM};
        pg8::gemm_phase<pg8::EpiRes, pg8::StaticOrderW<4>, true, true>(lds, g, S, E);
    }
}

extern "C" void kernel_launch(void* const* d_in, const int* in_sizes, int n_in, void* d_out, int out_size, void* d_ws, size_t ws_size, hipStream_t stream) {
    static int grid_blocks = 0;
    if (grid_blocks == 0) {
        if (n_in != 17 || out_size != M * DM || ws_size < WS_END) { fprintf(stderr, "kernel_launch: unexpected shapes (n_in %d out %d ws %zu)\n", n_in, out_size, ws_size); grid_blocks = -1; return; }
        int dev = 0, cus = 0, per_cu = 0;
        (void)hipGetDevice(&dev);
        (void)hipDeviceGetAttribute(&cus, hipDeviceAttributeMultiprocessorCount, dev);
        if (hipFuncSetAttribute((const void*)fwd_megakernel, hipFuncAttributeMaxDynamicSharedMemorySize, LDS_BYTES) != hipSuccess) { fprintf(stderr, "kernel_launch: hipFuncSetAttribute failed\n"); grid_blocks = -1; return; }
        if (hipOccupancyMaxActiveBlocksPerMultiprocessor(&per_cu, (const void*)fwd_megakernel, NTHR, LDS_BYTES) != hipSuccess || per_cu < 1) { fprintf(stderr, "kernel_launch: occupancy query says %d\n", per_cu); (void)hipGetLastError(); grid_blocks = -1; return; }
        grid_blocks = cus;
        fprintf(stderr, "kernel_launch: %d CUs, %d blocks/CU by occupancy, launching %d blocks\n", cus, per_cu, grid_blocks);
    }
    if (grid_blocks < 0) return;
    if (hipMemsetAsync((char*)d_ws + WS_BAR, 0, ZERO_BYTES, stream) != hipSuccess) { fprintf(stderr, "kernel_launch: memset failed\n"); return; }
    Args a{};
    for (int i = 0; i < 17; ++i) a.in[i] = (const float*)d_in[i];
    a.out = (float*)d_out; a.ws = (unsigned char*)d_ws;
    void* args[] = {&a};
    hipError_t e = hipLaunchCooperativeKernel((const void*)fwd_megakernel, dim3(grid_blocks), dim3(NTHR), args, LDS_BYTES, stream);
    if (e != hipSuccess) fprintf(stderr, "cooperative launch failed: %s (grid %d)\n", hipGetErrorString(e), grid_blocks);
}
```

```cpp
#include <hip/hip_runtime.h>
#include <hip/hip_cooperative_groups.h>
#include <cstdio>
#include <cstdint>
namespace cg = cooperative_groups;
namespace pg8 {
#define PG8_LAS __attribute__((address_space(3)))
typedef unsigned short bf16_t;
typedef short bf16x8 __attribute__((ext_vector_type(8)));
typedef float f32x4 __attribute__((ext_vector_type(4)));
typedef unsigned u32x4 __attribute__((ext_vector_type(4)));
constexpr int BM = 256, BK = 64, HALF = 128, HTB = HALF * BK * 2  , STAGE_BYTES = 8 * HTB, NXCD = 8, WGM = 8;

__host__ __device__ __forceinline__ int lds_byte(int r, int c) { const int st = (r >> 4) * 2 + (c >> 5), rr = r & 15, cc = c & 31, ob = rr * 64 + cc * 2; return st * 1024 + (ob ^ (((ob >> 9) & 1) << 5)); }
__host__ __device__ __forceinline__ void stage_rc(int b, int& R, int& C) { const int st = b / 1024, sb = b % 1024, swz = sb ^ (((sb >> 9) & 1) << 5); R = (st >> 1) * 16 + swz / 64; C = (st & 1) * 32 + (swz % 64) / 2; }
__host__ __device__ __forceinline__ int perm32(int rho) { const int n = rho >> 4, i = rho & 15; return 8 * (i >> 2) + 4 * n + (i & 3); }

struct Unit { int pm, pn; };
struct Gemm { const bf16_t* A; const bf16_t* Bt; int M, N, K; };

struct StaticOrder {
    int nM, nN, nwg, G, c;
    __host__ __device__ void init(int M, int N, int G_, int c_) { nM = M / BM; nN = N / BM; nwg = nM * nN; G = G_; c = c_; }
    __host__ __device__ bool next(int i, Unit& u) const {
        const long L = (long)i * G + c; if (L >= nwg) return false;
        int wgid = (int)L; { const int q = nwg / NXCD, r = nwg % NXCD, xcd = wgid % NXCD, off = wgid / NXCD; wgid = (xcd < r ? xcd * (q + 1) : r * (q + 1) + (xcd - r) * q) + off; }
        const int nig = WGM * nN, gid = wgid / nig, fm = gid * WGM, gsz = (nM - fm) < WGM ? (nM - fm) : WGM;
        u.pm = fm + ((wgid % nig) % gsz); u.pn = (wgid % nig) / gsz; return true;
    }
    __device__ __forceinline__ void a_ready(const Unit&) const {}
    __device__ __forceinline__ void done(const Unit&) const {}
};

__device__ __forceinline__ unsigned cvt_pk_bf16(float lo, float hi) { unsigned r; asm volatile("v_cvt_pk_bf16_f32 %0, %1, %2" : "=v"(r) : "v"(lo), "v"(hi)); return r; }
typedef float f32x2 __attribute__((ext_vector_type(2)));
typedef unsigned u32x2 __attribute__((ext_vector_type(2)));
__device__ __forceinline__ float bf2f(unsigned short h) { return __uint_as_float((unsigned)h << 16); }
__device__ __forceinline__ float bflo(unsigned w) { return __uint_as_float(w << 16); }
__device__ __forceinline__ float bfhi(unsigned w) { return __uint_as_float(w & 0xffff0000u); }

constexpr int PLD = 8704;
struct EpiIn {
    static constexpr bool PERM = true, AFTER_DRAIN = false;
    bf16_t* P; float* LOGF; const float* lbl;
    __device__ __forceinline__ void operator()(const f32x4 (&acc)[2][2][4][2], const Unit& u, int wr, int wc, int fr, int fq) const {
        const int pn = u.pn, row0 = u.pm * BM + wr * 64 + fr, colt = pn * BM + wc * 32 + 8 * fq;
        if (pn >= 4 && pn < 8) {
            float lbv[2][8];
#pragma unroll
            for (int bj = 0; bj < 2; ++bj)
#pragma unroll
                for (int e = 0; e < 8; ++e) { const int c = colt - 1024 + bj * HALF + e; lbv[bj][e] = 1.0f / (1.0f + __expf(lbl[1024 + c] - lbl[c])); }
#pragma unroll
            for (int ai = 0; ai < 2; ++ai)
#pragma unroll
                for (int m = 0; m < 4; ++m) { float* rowp = LOGF + (size_t)(row0 + ai * HALF + m * 16) * 1024 + (colt - 1024);
#pragma unroll
                    for (int bj = 0; bj < 2; ++bj)
#pragma unroll
                        for (int n = 0; n < 2; ++n) { f32x4 z = acc[ai][bj][m][n], o;
#pragma unroll
                            for (int e = 0; e < 4; ++e) { const float lb = lbv[bj][4 * n + e]; const float sg = 1.0f / (1.0f + __expf(-z[e])); o[e] = __logf(lb + (1.0f - lb) * sg); }
                            *(f32x4*)(rowp + bj * HALF + 4 * n) = o; } }
        } else {
            const int type = (pn < 4) ? 1 : (pn < 12) ? 0 : (pn < 16) ? 1 : (pn < 22) ? 0 : 2;
            const int pcol = (pn < 4) ? colt : colt - 1024;
#pragma unroll
            for (int ai = 0; ai < 2; ++ai)
#pragma unroll
                for (int m = 0; m < 4; ++m) { bf16_t* rowp = P + (size_t)(row0 + ai * HALF + m * 16) * PLD + pcol;
#pragma unroll
                    for (int bj = 0; bj < 2; ++bj) { float v[8];
#pragma unroll
                        for (int e = 0; e < 8; ++e) v[e] = acc[ai][bj][m][e >> 2][e & 3];
                        if (type != 0) {
#pragma unroll
                            for (int e = 0; e < 8; ++e) { const float sg = __builtin_amdgcn_rcpf(1.0f + __expf(-v[e])); v[e] = (type == 1) ? v[e] * sg : sg; } }
                        u32x4 w; w.x = cvt_pk_bf16(v[0], v[1]); w.y = cvt_pk_bf16(v[2], v[3]); w.z = cvt_pk_bf16(v[4], v[5]); w.w = cvt_pk_bf16(v[6], v[7]);
                        *(u32x4*)(rowp + bj * HALF) = w; } }
        }
    }
};
struct EpiMerge {
    static constexpr bool PERM = true, AFTER_DRAIN = false;
    const bf16_t* P; bf16_t* MG;
    __device__ __forceinline__ void operator()(const f32x4 (&acc)[2][2][4][2], const Unit& u, int wr, int wc, int fr, int fq) const {
        const int br = u.pm >= 64 ? 1 : 0, pm = u.pm & 63, pn = u.pn & 7;
        const int row0 = pm * BM + wr * 64 + fr, col0 = pn * BM + wc * 32 + 8 * fq, gcol = (br ? 4608 : 6656) + col0;
#pragma unroll
        for (int ai = 0; ai < 2; ++ai)
#pragma unroll
            for (int m = 0; m < 4; ++m) { const size_t row = (size_t)(row0 + ai * HALF + m * 16);
#pragma unroll
                for (int bj = 0; bj < 2; ++bj) {
                    const u32x4 g = *(const u32x4*)(P + row * PLD + gcol + bj * HALF);
                    bf16_t* mp = MG + row * 2048 + col0 + bj * HALF;
                    float v[8];
                    v[0] = acc[ai][bj][m][0][0] * bflo(g.x); v[1] = acc[ai][bj][m][0][1] * bfhi(g.x); v[2] = acc[ai][bj][m][0][2] * bflo(g.y); v[3] = acc[ai][bj][m][0][3] * bfhi(g.y);
                    v[4] = acc[ai][bj][m][1][0] * bflo(g.z); v[5] = acc[ai][bj][m][1][1] * bfhi(g.z); v[6] = acc[ai][bj][m][1][2] * bflo(g.w); v[7] = acc[ai][bj][m][1][3] * bfhi(g.w);
                    if (br) { const u32x4 p = *(const u32x4*)mp;
                        v[0] += bflo(p.x); v[1] += bfhi(p.x); v[2] += bflo(p.y); v[3] += bfhi(p.y); v[4] += bflo(p.z); v[5] += bfhi(p.z); v[6] += bflo(p.w); v[7] += bfhi(p.w); }
                    u32x4 w; w.x = cvt_pk_bf16(v[0], v[1]); w.y = cvt_pk_bf16(v[2], v[3]); w.z = cvt_pk_bf16(v[4], v[5]); w.w = cvt_pk_bf16(v[6], v[7]);
                    *(u32x4*)mp = w; } }
    }
};
template <int WG> struct StaticOrderW {
    int nM, nN, nwg, G, c;
    __device__ void init(int M, int N, int G_, int c_) { nM = M / BM; nN = N / BM; nwg = nM * nN; G = G_; c = c_; }
    __device__ bool next(int i, Unit& u) const {
        const long L = (long)i * G + c; if (L >= nwg) return false;
        int wgid = (int)L; { const int q = nwg / NXCD, r = nwg % NXCD, xcd = wgid % NXCD, off = wgid / NXCD; wgid = (xcd < r ? xcd * (q + 1) : r * (q + 1) + (xcd - r) * q) + off; }
        const int nig = WG * nN, gid = wgid / nig, fm = gid * WG, gsz = (nM - fm) < WG ? (nM - fm) : WG;
        u.pm = fm + ((wgid % nig) % gsz); u.pn = (wgid % nig) / gsz; return true;
    }
    __device__ __forceinline__ void a_ready(const Unit&) const {}
    __device__ __forceinline__ void done(const Unit&) const {}
};
struct PairOrder {
    StaticOrderW<4> base;
    __device__ __forceinline__ bool next(int i, Unit& u) const { if (!base.next(i >> 1, u)) return false; if (i & 1) { u.pm += 64; u.pn += 8; } return true; }
    __device__ __forceinline__ void a_ready(const Unit&) const {}
    __device__ __forceinline__ void done(const Unit&) const {}
};
struct EpiRes {
    static constexpr bool PERM = false, AFTER_DRAIN = false;
    const float* base; float* out; const float* gate;
    __device__ __forceinline__ void operator()(const f32x4 (&acc)[2][2][4][2], const Unit& u, int wr, int wc, int fr, int fq) const {
        const int row0 = u.pm * BM + wr * 64 + fr, col0 = u.pn * BM + wc * 32 + 4 * fq, b = (u.pm * BM) >> 12;
        f32x4 gv[2][2];
#pragma unroll
        for (int bj = 0; bj < 2; ++bj)
#pragma unroll
            for (int n = 0; n < 2; ++n) gv[bj][n] = *(const f32x4*)(gate + (size_t)b * 12288 + col0 + bj * HALF + n * 16);
#pragma unroll
        for (int ai = 0; ai < 2; ++ai)
#pragma unroll
            for (int m = 0; m < 4; ++m) { const size_t off = (size_t)(row0 + ai * HALF + m * 16) * 2048 + col0;
#pragma unroll
                for (int bj = 0; bj < 2; ++bj)
#pragma unroll
                    for (int n = 0; n < 2; ++n) { const f32x4 bs = __builtin_nontemporal_load((const f32x4*)(base + off + bj * HALF + n * 16));
                        *(f32x4*)(out + off + bj * HALF + n * 16) = bs + gv[bj][n] * acc[ai][bj][m][n]; } }
    }
};
struct EpiRelu2 {
    static constexpr bool PERM = true, AFTER_DRAIN = false;
    bf16_t* O; int ldc;
    __device__ __forceinline__ void operator()(const f32x4 (&acc)[2][2][4][2], const Unit& u, int wr, int wc, int fr, int fq) const {
        const int row0 = u.pm * BM + wr * 64 + fr, col0 = u.pn * BM + wc * 32 + 8 * fq;
#pragma unroll
        for (int ai = 0; ai < 2; ++ai)
#pragma unroll
            for (int m = 0; m < 4; ++m) { bf16_t* rowp = O + (size_t)(row0 + ai * HALF + m * 16) * ldc + col0;
#pragma unroll
                for (int bj = 0; bj < 2; ++bj) { float v[8];
#pragma unroll
                    for (int e = 0; e < 8; ++e) { const float x = fmaxf(acc[ai][bj][m][e >> 2][e & 3], 0.f); v[e] = x * x; }
                    u32x4 w; w.x = cvt_pk_bf16(v[0], v[1]); w.y = cvt_pk_bf16(v[2], v[3]); w.z = cvt_pk_bf16(v[4], v[5]); w.w = cvt_pk_bf16(v[6], v[7]);
                    *(u32x4*)(rowp + bj * HALF) = w; } }
    }
};

struct EpiRes2 {
    static constexpr bool PERM = false, AFTER_DRAIN = false;
    const float* base; float* out; const float* mod; const float* g2; bf16_t* A2; float* rowss;
    __device__ __forceinline__ void operator()(const f32x4 (&acc)[2][2][4][2], const Unit& u, int wr, int wc, int fr, int fq) const {
        const int row0 = u.pm * BM + wr * 64 + fr, col0 = u.pn * BM + wc * 32 + 4 * fq, b = (u.pm * BM) >> 12;
        f32x4 gv[2][2], Gv[2][2];
#pragma unroll
        for (int bj = 0; bj < 2; ++bj)
#pragma unroll
            for (int n = 0; n < 2; ++n) { const int c = col0 + bj * HALF + n * 16; gv[bj][n] = *(const f32x4*)(mod + (size_t)b * 12288 + 2 * 2048 + c);
                Gv[bj][n] = *(const f32x4*)(g2 + c) * (*(const f32x4*)(mod + (size_t)b * 12288 + 4 * 2048 + c) + 1.0f); }
#pragma unroll
        for (int ai = 0; ai < 2; ++ai)
#pragma unroll
            for (int m = 0; m < 4; ++m) { const int row = row0 + ai * HALF + m * 16; const size_t off = (size_t)row * 2048 + col0; float ss = 0.f;
#pragma unroll
                for (int bj = 0; bj < 2; ++bj)
#pragma unroll
                    for (int n = 0; n < 2; ++n) { const f32x4 bs = *(const f32x4*)(base + off + bj * HALF + n * 16); const f32x4 x1 = bs + gv[bj][n] * acc[ai][bj][m][n];
                        *(f32x4*)(out + off + bj * HALF + n * 16) = x1; ss += (x1.x * x1.x + x1.y * x1.y) + (x1.z * x1.z + x1.w * x1.w);
                        const f32x4 hh = x1 * Gv[bj][n]; u32x2 w; w.x = cvt_pk_bf16(hh.x, hh.y); w.y = cvt_pk_bf16(hh.z, hh.w); *(u32x2*)(A2 + off + bj * HALF + n * 16) = w; }
                ss += __shfl_xor(ss, 16); ss += __shfl_xor(ss, 32);
                if (fq == 0) __hip_atomic_fetch_add(rowss + row, ss, __ATOMIC_RELAXED, __HIP_MEMORY_SCOPE_AGENT); }
    }
};
struct EpiUp {
    static constexpr bool PERM = true, AFTER_DRAIN = false;
    bf16_t* O; int ldc; const float* rowss; const float* cb;
    __device__ __forceinline__ void operator()(const f32x4 (&acc)[2][2][4][2], const Unit& u, int wr, int wc, int fr, int fq) const {
        const int row0 = u.pm * BM + wr * 64 + fr, col0 = u.pn * BM + wc * 32 + 8 * fq, b = (u.pm * BM) >> 12;
        f32x4 cbv[2][2];
#pragma unroll
        for (int bj = 0; bj < 2; ++bj)
#pragma unroll
            for (int n = 0; n < 2; ++n) cbv[bj][n] = *(const f32x4*)(cb + (size_t)b * 8192 + col0 + bj * HALF + 4 * n);
#pragma unroll
        for (int ai = 0; ai < 2; ++ai)
#pragma unroll
            for (int m = 0; m < 4; ++m) { const int row = row0 + ai * HALF + m * 16; bf16_t* rowp = O + (size_t)row * ldc + col0;
                const float rstd = 1.0f / sqrtf(__hip_atomic_load(rowss + row, __ATOMIC_RELAXED, __HIP_MEMORY_SCOPE_AGENT) * (1.0f / 2048.0f) + 1e-6f);
#pragma unroll
                for (int bj = 0; bj < 2; ++bj) { float v[8];
#pragma unroll
                    for (int e = 0; e < 8; ++e) { const float x = fmaxf(acc[ai][bj][m][e >> 2][e & 3] * rstd + cbv[bj][e >> 2][e & 3], 0.f); v[e] = x * x; }
                    u32x4 w; w.x = cvt_pk_bf16(v[0], v[1]); w.y = cvt_pk_bf16(v[2], v[3]); w.z = cvt_pk_bf16(v[4], v[5]); w.w = cvt_pk_bf16(v[6], v[7]);
                    *(u32x4*)(rowp + bj * HALF) = w; } }
    }
};

struct EpiRes3 {
    static constexpr bool PERM = false, AFTER_DRAIN = false;
    const float* base; float* out; const float* mod; const float* g2; bf16_t* A2; float* part;
    __device__ __forceinline__ void operator()(const f32x4 (&acc)[2][2][4][2], const Unit& u, int wr, int wc, int fr, int fq) const {
        const int row0 = u.pm * BM + wr * 64 + fr, col0 = u.pn * BM + wc * 32 + 4 * fq, b = (u.pm * BM) >> 12;
        f32x4 gv[2][2], Gv[2][2];
#pragma unroll
        for (int bj = 0; bj < 2; ++bj)
#pragma unroll
            for (int n = 0; n < 2; ++n) { const int c = col0 + bj * HALF + n * 16; gv[bj][n] = *(const f32x4*)(mod + (size_t)b * 12288 + 2 * 2048 + c);
                Gv[bj][n] = *(const f32x4*)(g2 + c) * (*(const f32x4*)(mod + (size_t)b * 12288 + 4 * 2048 + c) + 1.0f); }
        float* prow = part + (size_t)(u.pn * 4 + wc) * 16384;
#pragma unroll
        for (int ai = 0; ai < 2; ++ai)
#pragma unroll
            for (int m = 0; m < 4; ++m) { const int row = row0 + ai * HALF + m * 16; const size_t off = (size_t)row * 2048 + col0; float ss = 0.f;
#pragma unroll
                for (int bj = 0; bj < 2; ++bj)
#pragma unroll
                    for (int n = 0; n < 2; ++n) { const f32x4 bs = __builtin_nontemporal_load((const f32x4*)(base + off + bj * HALF + n * 16)); const f32x4 x1 = bs + gv[bj][n] * acc[ai][bj][m][n];
                        *(f32x4*)(out + off + bj * HALF + n * 16) = x1; ss += (x1.x * x1.x + x1.y * x1.y) + (x1.z * x1.z + x1.w * x1.w);
                        const f32x4 hh = x1 * Gv[bj][n]; u32x2 w; w.x = cvt_pk_bf16(hh.x, hh.y); w.y = cvt_pk_bf16(hh.z, hh.w); *(u32x2*)(A2 + off + bj * HALF + n * 16) = w; }
                ss += __shfl_xor(ss, 16); ss += __shfl_xor(ss, 32);
                if (fq == 0) prow[row] = ss; }
    }
};
struct EpiUp2 {
    static constexpr bool PERM = true, AFTER_DRAIN = false;
    bf16_t* O; int ldc; const PG8_LAS float* rstd; const float* cb;
    __device__ __forceinline__ void operator()(const f32x4 (&acc)[2][2][4][2], const Unit& u, int wr, int wc, int fr, int fq) const {
        const int row0 = u.pm * BM + wr * 64 + fr, col0 = u.pn * BM + wc * 32 + 8 * fq, b = (u.pm * BM) >> 12;
        f32x4 cbv[2][2];
#pragma unroll
        for (int bj = 0; bj < 2; ++bj)
#pragma unroll
            for (int n = 0; n < 2; ++n) cbv[bj][n] = *(const f32x4*)(cb + (size_t)b * 8192 + col0 + bj * HALF + 4 * n);
#pragma unroll
        for (int ai = 0; ai < 2; ++ai)
#pragma unroll
            for (int m = 0; m < 4; ++m) { const int rl = wr * 64 + fr + ai * HALF + m * 16; bf16_t* rowp = O + (size_t)(u.pm * BM + rl) * ldc + col0;
                const float rs = rstd[((u.pm >> 2) & 1) * 256 + rl];
#pragma unroll
                for (int bj = 0; bj < 2; ++bj) { float v[8];
#pragma unroll
                    for (int e = 0; e < 8; ++e) { const float x = fmaxf(acc[ai][bj][m][e >> 2][e & 3] * rs + cbv[bj][e >> 2][e & 3], 0.f); v[e] = x * x; }
                    u32x4 w; w.x = cvt_pk_bf16(v[0], v[1]); w.y = cvt_pk_bf16(v[2], v[3]); w.z = cvt_pk_bf16(v[4], v[5]); w.w = cvt_pk_bf16(v[6], v[7]);
                    *(u32x4*)(rowp + bj * HALF) = w; } }
    }
};

struct InOrder {
    StaticOrderW<4> base;
    __device__ __forceinline__ bool next(int i, Unit& u) const { if (!base.next(i, u)) return false; const int p = u.pn;
        u.pn = p < 16 ? 22 + p : p < 20 ? p - 16 : p < 24 ? p - 20 + 12 : p < 28 ? p - 24 + 4 : p < 32 ? p - 28 + 8 : p - 32 + 16; return true; }
    __device__ __forceinline__ void a_ready(const Unit&) const {}
    __device__ __forceinline__ void done(const Unit&) const {}
};
template <class Epi, class Sched, bool ALIGN_EPI = false, bool SP2 = false>
__device__ __forceinline__ void gemm_phase(PG8_LAS unsigned char* lds, const Gemm g, const Sched& S, const Epi& E) {
    int tid_ = threadIdx.x; asm volatile("" : "+v"(tid_));
    const int tid = tid_, wid = __builtin_amdgcn_readfirstlane(tid >> 6), lane = tid & 63, wr = wid >> 2, wc = wid & 3, fr = lane & 15, fq = lane >> 4;
    const int K = g.K, nt = K / BK;
    unsigned voffA[2], voffB[2];
#pragma unroll
    for (int i = 0; i < 2; ++i) { int R, C; stage_rc(tid * 16 + i * 8192, R, C); const int Rb = Epi::PERM ? ((R & ~31) + perm32(R & 31)) : R;
        voffA[i] = (unsigned)(R * K + C) * 2u; voffB[i] = (unsigned)(Rb * K + C) * 2u; }
    const size_t kstep = (size_t)(BK * 2);
    const size_t hstep = (size_t)HALF * K * 2;
    const size_t tstep = 2 * hstep;
    const unsigned ldsw = (unsigned)wid * 1024u;
    const int aoff = lds_byte(wr * 64 + fr, fq * 8), boff = lds_byte(wc * 32 + fr, fq * 8);
#define PG8_SA(b, h) (((b) * 2 + (h)) * HTB)
#define PG8_SB(b, h) ((4 + (b) * 2 + (h)) * HTB)
#define PG8_STAGE(bufoff, gbase, voff) do { _Pragma("unroll") for (int _i = 0; _i < 2; ++_i) \
        __builtin_amdgcn_global_load_lds((const unsigned*)((const char*)(gbase) + (voff)[_i]), (PG8_LAS unsigned*)(lds + (bufoff) + ldsw + _i * 8192), 16, 0, 0); } while (0)
#define PG8_LDA(dst, b, h) do { _Pragma("unroll") for (int m = 0; m < 4; ++m) _Pragma("unroll") for (int k = 0; k < 2; ++k) dst[m][k] = *(const PG8_LAS bf16x8*)(lds + PG8_SA(b, h) + aoff + m * 2048 + k * 1024); } while (0)
#define PG8_LDB(dst, b, h) do { _Pragma("unroll") for (int n = 0; n < 2; ++n) _Pragma("unroll") for (int k = 0; k < 2; ++k) dst[n][k] = *(const PG8_LAS bf16x8*)(lds + PG8_SB(b, h) + boff + n * 2048 + k * 1024); } while (0)
#define PG8_MMA(ai, bj, At, Bt) do { __builtin_amdgcn_s_setprio(1); _Pragma("unroll") for (int m = 0; m < 4; ++m) _Pragma("unroll") for (int n = 0; n < 2; ++n) _Pragma("unroll") for (int k = 0; k < 2; ++k) \
        acc[ai][bj][m][n] = __builtin_amdgcn_mfma_f32_16x16x32_bf16(Bt[n][k], At[m][k], acc[ai][bj][m][n], 0, 0, 0); __builtin_amdgcn_s_setprio(0); } while (0)
#define PG8_WAIT_V(n) asm volatile("s_waitcnt vmcnt(" #n ")" ::: "memory")
#define PG8_WAIT_L(n) asm volatile("s_waitcnt lgkmcnt(" #n ")" ::: "memory")
#define PG8_BAR __builtin_amdgcn_s_barrier()
#define PG8_SCHED __builtin_amdgcn_sched_barrier(0)
    Unit cur, nxt; int ui = 0;
    if (!S.next(0, cur)) return;
    f32x4 acc[2][2][4][2];
#pragma unroll
    for (int a = 0; a < 2; ++a)
#pragma unroll
        for (int b = 0; b < 2; ++b)
#pragma unroll
            for (int m = 0; m < 4; ++m)
#pragma unroll
                for (int n = 0; n < 2; ++n) acc[a][b][m][n] = (f32x4){0.f, 0.f, 0.f, 0.f};
    bf16x8 At[4][2], B0[2][2], B1[2][2];
    const char* cA = (const char*)g.A + (size_t)cur.pm * tstep; const char* cB = (const char*)g.Bt + (size_t)cur.pn * tstep;
    S.a_ready(cur);
    if constexpr (SP2) {
        PG8_STAGE(PG8_SB(0, 0), cB, voffB); PG8_STAGE(PG8_SB(0, 1), cB + hstep, voffB); PG8_STAGE(PG8_SA(0, 0), cA, voffA); PG8_STAGE(PG8_SA(0, 1), cA + hstep, voffA);
        if (wr == 1) PG8_BAR;
        PG8_WAIT_V(2); PG8_BAR;
        PG8_STAGE(PG8_SB(1, 0), cB + kstep, voffB); PG8_STAGE(PG8_SA(1, 0), cA + kstep, voffA); PG8_STAGE(PG8_SB(1, 1), cB + hstep + kstep, voffB);
        PG8_WAIT_V(6); PG8_BAR;
    } else {
        PG8_STAGE(PG8_SB(0, 0), cB, voffB); PG8_STAGE(PG8_SA(0, 0), cA, voffA); PG8_STAGE(PG8_SB(0, 1), cB + hstep, voffB); PG8_STAGE(PG8_SA(0, 1), cA + hstep, voffA);
        if (wr == 1) PG8_BAR;
        PG8_WAIT_V(4); PG8_BAR;
        PG8_STAGE(PG8_SB(1, 0), cB + kstep, voffB); PG8_STAGE(PG8_SA(1, 0), cA + kstep, voffA); PG8_STAGE(PG8_SB(1, 1), cB + hstep + kstep, voffB);
        PG8_WAIT_V(6); PG8_BAR;
    }
    for (;;) {
        const bool has_next = S.next(ui + 1, nxt);
        const char* nA = has_next ? (const char*)g.A + (size_t)nxt.pm * tstep : cA; const char* nB = has_next ? (const char*)g.Bt + (size_t)nxt.pn * tstep : cB;
        for (int t = 0; t < nt; t += 2) {
            const bool last = (t == nt - 2);
            const char* a1 = cA + (size_t)(t + 1) * kstep;
            const char* a2 = last ? nA : cA + (size_t)(t + 2) * kstep; const char* b2 = last ? nB : cB + (size_t)(t + 2) * kstep;
            const char* a3 = a2 + kstep; const char* b3 = b2 + kstep;
            if (last && has_next) S.a_ready(nxt);
            if constexpr (SP2) {
            PG8_LDB(B0, 0, 0); PG8_LDB(B1, 0, 1); PG8_SCHED; PG8_LDA(At, 0, 0); PG8_STAGE(PG8_SA(1, 1), a1 + hstep, voffA);
            PG8_WAIT_V(8); PG8_WAIT_L(0); PG8_BAR; PG8_MMA(0, 0, At, B0); PG8_MMA(0, 1, At, B1); PG8_BAR; PG8_SCHED;
            PG8_LDA(At, 0, 1); PG8_STAGE(PG8_SB(0, 0), b2, voffB); PG8_STAGE(PG8_SB(0, 1), b2 + hstep, voffB); PG8_STAGE(PG8_SA(0, 0), a2, voffA);
            PG8_WAIT_V(8); PG8_WAIT_L(0); PG8_BAR; PG8_MMA(1, 0, At, B0); PG8_MMA(1, 1, At, B1); PG8_BAR; PG8_SCHED;
            PG8_LDB(B0, 1, 0); PG8_LDB(B1, 1, 1); PG8_SCHED; PG8_LDA(At, 1, 0); PG8_STAGE(PG8_SA(0, 1), a2 + hstep, voffA);
            PG8_WAIT_V(8); PG8_WAIT_L(0); PG8_BAR; PG8_MMA(0, 0, At, B0); PG8_MMA(0, 1, At, B1); PG8_BAR; PG8_SCHED;
            PG8_LDA(At, 1, 1); PG8_STAGE(PG8_SB(1, 0), b3, voffB); PG8_STAGE(PG8_SB(1, 1), b3 + hstep, voffB); PG8_STAGE(PG8_SA(1, 0), a3, voffA);
            PG8_WAIT_V(8); PG8_WAIT_L(0); PG8_BAR; PG8_MMA(1, 0, At, B0); PG8_MMA(1, 1, At, B1); PG8_BAR; PG8_SCHED;
            } else {
            PG8_LDB(B0, 0, 0); PG8_SCHED; PG8_LDA(At, 0, 0); PG8_STAGE(PG8_SA(1, 1), a1 + hstep, voffA);
            PG8_WAIT_L(8); PG8_BAR; PG8_WAIT_L(0); PG8_MMA(0, 0, At, B0); PG8_BAR; PG8_SCHED;
            PG8_LDB(B1, 0, 1); PG8_STAGE(PG8_SB(0, 0), b2, voffB);
            PG8_BAR; PG8_WAIT_L(0); PG8_MMA(0, 1, At, B1); PG8_BAR;
            PG8_LDA(At, 0, 1); PG8_STAGE(PG8_SA(0, 0), a2, voffA);
            PG8_BAR; PG8_WAIT_L(0); PG8_MMA(1, 0, At, B0); PG8_BAR; PG8_SCHED;
            PG8_STAGE(PG8_SB(0, 1), b2 + hstep, voffB);
            PG8_WAIT_V(6); PG8_BAR; PG8_MMA(1, 1, At, B1); PG8_BAR;
            PG8_LDB(B0, 1, 0); PG8_SCHED; PG8_LDA(At, 1, 0); PG8_STAGE(PG8_SA(0, 1), a2 + hstep, voffA);
            PG8_WAIT_L(8); PG8_BAR; PG8_WAIT_L(0); PG8_MMA(0, 0, At, B0); PG8_BAR; PG8_SCHED;
            PG8_LDB(B1, 1, 1); PG8_STAGE(PG8_SB(1, 0), b3, voffB);
            PG8_BAR; PG8_WAIT_L(0); PG8_MMA(0, 1, At, B1); PG8_BAR;
            PG8_LDA(At, 1, 1); PG8_STAGE(PG8_SA(1, 0), a3, voffA);
            PG8_BAR; PG8_WAIT_L(0); PG8_MMA(1, 0, At, B0); PG8_BAR; PG8_SCHED;
            PG8_STAGE(PG8_SB(1, 1), b3 + hstep, voffB);
            PG8_WAIT_V(6); PG8_BAR; PG8_MMA(1, 1, At, B1); PG8_BAR;
            }
        }
        if constexpr (ALIGN_EPI) { if (wr == 0) PG8_BAR; }
        if constexpr (!Epi::AFTER_DRAIN) { E(acc, cur, wr, wc, fr, fq); S.done(cur); }
        if (!has_next) break;
#pragma unroll
        for (int a = 0; a < 2; ++a)
#pragma unroll
            for (int b = 0; b < 2; ++b)
#pragma unroll
                for (int m = 0; m < 4; ++m)
#pragma unroll
                    for (int n = 0; n < 2; ++n) acc[a][b][m][n] = (f32x4){0.f, 0.f, 0.f, 0.f};
        cur = nxt; cA = nA; cB = nB; ++ui;
        if constexpr (ALIGN_EPI) { if (wr == 1) PG8_BAR; }
    }
    PG8_WAIT_V(0);
    if constexpr (!ALIGN_EPI) { if (wr == 0) PG8_BAR; }
    PG8_BAR;
    if constexpr (Epi::AFTER_DRAIN) { E.fused(acc, cur, wr, wc, fr, fq, lds, wid, lane); S.done(cur); }
#undef PG8_SA
#undef PG8_SB
#undef PG8_STAGE
#undef PG8_LDA
#undef PG8_LDB
#undef PG8_MMA
#undef PG8_WAIT_V
#undef PG8_WAIT_L
#undef PG8_BAR
#undef PG8_SCHED
}
}
#define LAS __attribute__((address_space(3)))
typedef unsigned short bf16_t;
typedef short bf16x8 __attribute__((ext_vector_type(8)));
typedef float f32x4 __attribute__((ext_vector_type(4)));
typedef unsigned u32x4 __attribute__((ext_vector_type(4)));
typedef unsigned u32x2 __attribute__((ext_vector_type(2)));
using pg8::cvt_pk_bf16; using pg8::bflo; using pg8::bfhi; using pg8::bf2f; using pg8::PLD;
constexpr int DM = 2048, SEQ = 4096, NB = 4, M = NB * SEQ, INW = 9728, HID = 8192, NMOD = 6 * DM;
constexpr float EPS = 1e-6f;
constexpr size_t MiB = 1u << 20;
constexpr size_t WS_MOD = 0, WS_WIN = 1 * MiB, WS_WAB = 39 * MiB, WS_WO = 47 * MiB, WS_W1 = 55 * MiB, WS_W2 = 87 * MiB, WS_H = 120 * MiB, WS_P = 184 * MiB, WS_SSEG = 456 * MiB, WS_DSEG = 472 * MiB, WS_H2 = 440 * MiB, WS_PART = 504 * MiB, WS_END = 506 * MiB;
constexpr size_t WS_CB = 256 * 1024;
constexpr size_t WS_BAR = 512 * 1024, BAR_BYTES = 16384, WS_ROWSS = WS_BAR + BAR_BYTES, ZERO_BYTES = BAR_BYTES;
constexpr int MISC_OFF = 147456 - 64;
constexpr int LDS_BYTES = 147456;
constexpr int NTHR = 512;

__device__ __forceinline__ float wave_sum(float v) {
#pragma unroll
    for (int o = 1; o < 64; o <<= 1) v += __shfl_xor(v, o);
    return v;
}
__device__ __forceinline__ bf16x8 ldfrag(const LAS bf16_t* base, int pitch, int row, int kofs) { return *(const LAS bf16x8*)(base + row * pitch + kofs); }
#define MFMA16(a, b, c) __builtin_amdgcn_mfma_f32_16x16x32_bf16((a), (b), (c), 0, 0, 0)
#define LBAR() do { asm volatile("s_waitcnt lgkmcnt(0)" ::: "memory"); __builtin_amdgcn_s_barrier(); asm volatile("" ::: "memory"); } while (0)
#define XB_TMO      128
#define XB_XCNT(j)  (256  + 64 * (j))
#define XB_XSUB(j)  (1280 + 64 * (j))
#define XB_XGEN(j)  (2304 + 64 * (j))
#define XB_TOP      3328
#define XB_TOPGEN   3392
#define XCD_BAR_WORDS 3456
#define XB_SPIN_CAP (1u << 18)

__device__ __forceinline__ unsigned xb_ld(unsigned* p)              { return __hip_atomic_load(p, __ATOMIC_RELAXED, __HIP_MEMORY_SCOPE_AGENT); }
__device__ __forceinline__ unsigned xb_add(unsigned* p, unsigned v) { return __hip_atomic_fetch_add(p, v, __ATOMIC_RELAXED, __HIP_MEMORY_SCOPE_AGENT); }
__device__ __forceinline__ unsigned xb_xcc_id() { return (unsigned)__builtin_amdgcn_s_getreg((3 << 11) | 20) & 0xFu; }
#define XB_SPIN(cond, bar) do { unsigned _sp = 0; while (cond) { __builtin_amdgcn_s_sleep(1); \
    if ((++_sp & 255u) == 0u) { if (xb_ld(&(bar)[XB_TMO])) break; if (_sp > XB_SPIN_CAP) { atomicAdd(&(bar)[XB_TMO], 1u); break; } } } } while (0)

struct XcdBarrier {
    unsigned* bar; unsigned x;
    volatile LAS unsigned* st;
};

__device__ __forceinline__ XcdBarrier xcd_barrier_post(unsigned* bar, volatile LAS unsigned* st) {
    XcdBarrier b; b.bar = bar; b.x = xb_xcc_id(); b.st = st;
    if (threadIdx.x == 0) (void)xb_add(&bar[XB_XCNT(b.x)], 1u);
    return b;
}
__device__ __forceinline__ void xcd_barrier_complete(unsigned* bar, unsigned x, unsigned& nloc, unsigned& nx) {
    const unsigned G = gridDim.x * gridDim.y * gridDim.z;
    unsigned sum, cnt, mine, sp = 0u;
    for (;;) {
        sum = 0u; cnt = 0u; mine = 0u;
#pragma unroll
        for (unsigned j = 0; j < 16; ++j) { const unsigned c = xb_ld(&bar[XB_XCNT(j)]); sum += c; cnt += (c > 0u) ? 1u : 0u; mine = (j == x) ? c : mine; }
        if (sum == G) break;
        __builtin_amdgcn_s_sleep(1);
        if ((++sp & 255u) == 0u) { if (xb_ld(&bar[XB_TMO])) break; if (sp > XB_SPIN_CAP) { atomicAdd(&bar[XB_TMO], 1u); break; } }
    }
    nloc = mine > 0u ? mine : 1u; nx = cnt > 0u ? cnt : 1u;
}

__device__ __forceinline__ void xcd_barrier(const XcdBarrier& b) {
    asm volatile("s_waitcnt vmcnt(0)" ::: "memory");
    __syncthreads();
    if (threadIdx.x == 0) {
        unsigned* bar = b.bar;
        __builtin_amdgcn_s_waitcnt(0);
        unsigned nloc = b.st[0], nx = b.st[1];
        if (nloc == 0u) { xcd_barrier_complete(bar, b.x, nloc, nx); b.st[0] = nloc; b.st[1] = nx; }
        const unsigned old = xb_add(&bar[XB_XSUB(b.x)], 1u);
        const unsigned gen = old / nloc;
        if (old + 1u == (gen + 1u) * nloc) {
            __builtin_amdgcn_fence(__ATOMIC_RELEASE, "agent");
            asm volatile("s_waitcnt vmcnt(0)" ::: "memory");
            const unsigned og = xb_add(&bar[XB_TOP], 1u);
            const unsigned tg = og / nx;
            if (og + 1u == (tg + 1u) * nx) xb_add(&bar[XB_TOPGEN], 1u);
            else XB_SPIN(xb_ld(&bar[XB_TOPGEN]) == tg, bar);
            __builtin_amdgcn_fence(__ATOMIC_ACQUIRE, "agent");
            xb_add(&bar[XB_XGEN(b.x)], 1u);
            asm volatile("s_waitcnt vmcnt(0)" ::: "memory");
        } else {
            XB_SPIN(xb_ld(&bar[XB_XGEN(b.x)]) == gen, bar);
            __builtin_amdgcn_fence(__ATOMIC_ACQUIRE, "agent");
            asm volatile("s_waitcnt vmcnt(0)" ::: "memory");
        }
    }
    __syncthreads();
}


struct TrDesc { const float* W; bf16_t* WT; int K, N, row_off, item; };
__device__ __forceinline__ void tr_load(const TrDesc& d, int lane, f32x4 (&v)[16]) {
    const int nkb = d.K / 64, kb = d.item % nkb, nb = d.item / nkb, k0 = 64 * kb, n0 = 64 * nb;
    const float* p = d.W + (size_t)(k0 + (lane >> 4)) * d.N + n0 + 4 * (lane & 15);
#pragma unroll
    for (int i = 0; i < 16; ++i) v[i] = __builtin_nontemporal_load((const f32x4*)(p + (size_t)(4 * i) * d.N));
}
__device__ __forceinline__ void tr_store(const TrDesc& d, int lane, const f32x4 (&v)[16], LAS float* scr) {
    const int nkb = d.K / 64, kb = d.item % nkb, nb = d.item / nkb, k0 = 64 * kb, n0 = 64 * nb;
#pragma unroll
    for (int i = 0; i < 16; ++i) { LAS float* s = scr + (4 * i + (lane >> 4)) * 65 + 4 * (lane & 15); s[0] = v[i].x; s[1] = v[i].y; s[2] = v[i].z; s[3] = v[i].w; }
    __builtin_amdgcn_wave_barrier();
    const int c = lane & 7;
#pragma unroll
    for (int j = 0; j < 8; ++j) { const int n = (lane >> 3) + 8 * j; const LAS float* s = scr + (8 * c) * 65 + n;
        u32x4 o; o.x = cvt_pk_bf16(s[0 * 65], s[1 * 65]); o.y = cvt_pk_bf16(s[2 * 65], s[3 * 65]); o.z = cvt_pk_bf16(s[4 * 65], s[5 * 65]); o.w = cvt_pk_bf16(s[6 * 65], s[7 * 65]);
        *(u32x4*)(d.WT + (size_t)(d.row_off + n0 + n) * d.K + k0 + 8 * c) = o; }
    __builtin_amdgcn_wave_barrier();
}
__device__ __forceinline__ void gemv_item(const float* __restrict__ cvec, const float* __restrict__ Wada, const float* __restrict__ bada, float* mod, LAS unsigned char* lds, int item, int tid) {
    LAS f32x4* sc = (LAS f32x4*)lds;
    LAS float* red = (LAS float*)(lds + 32768);
    for (int k = tid; k < DM; k += NTHR) { f32x4 v;
#pragma unroll
        for (int b = 0; b < 4; ++b) { const float x = cvec[b * DM + k]; v[b] = x / (1.0f + __expf(-x)); }
        sc[k] = v; }
    __syncthreads();
    const int c4 = tid % 12, rl = tid / 12, n0 = item * 48;
    f32x4 a0 = {0.f, 0.f, 0.f, 0.f}, a1 = a0, a2 = a0, a3 = a0;
    if (rl < 42) {
        const float* wp = Wada + n0 + 4 * c4;
#pragma unroll 8
        for (int k = rl; k < DM; k += 42) { const f32x4 w = __builtin_nontemporal_load((const f32x4*)(wp + (size_t)k * NMOD)); const f32x4 s = sc[k]; a0 += w * s.x; a1 += w * s.y; a2 += w * s.z; a3 += w * s.w; }
        LAS f32x4* r = (LAS f32x4*)red + (rl * 12 + c4) * 4; r[0] = a0; r[1] = a1; r[2] = a2; r[3] = a3;
    }
    __syncthreads();
    if (tid < 192) { const int b = tid / 48, col = tid % 48, cc = col >> 2, e = col & 3; float s = 0.f;
        for (int r = 0; r < 42; ++r) s += red[((r * 12 + cc) * 4 + b) * 4 + e];
        mod[(size_t)b * NMOD + n0 + col] = s + bada[n0 + col]; }
    __syncthreads();
}
__device__ __forceinline__ void norm_phase(const float* X, const float* __restrict__ gain, const float* mod, int sh_off, int sc_off, bf16_t* H, int gw, int NGW, int lane) {
    for (int rg = gw; rg < M / 8; rg += NGW) {
        const int row0 = rg * 8, b = row0 >> 12;
        f32x4 gs[8], sh[8];
#pragma unroll
        for (int j = 0; j < 8; ++j) { const f32x4 g = ((const f32x4*)gain)[lane + 64 * j]; const f32x4 s = ((const f32x4*)(mod + (size_t)b * NMOD + sc_off))[lane + 64 * j];
            gs[j] = g * (s + 1.0f); sh[j] = ((const f32x4*)(mod + (size_t)b * NMOD + sh_off))[lane + 64 * j]; }
        for (int r = 0; r < 8; ++r) {
            const f32x4* xr = (const f32x4*)(X + (size_t)(row0 + r) * DM) + lane;
            f32x4 v[8]; float ss = 0.f;
#pragma unroll
            for (int j = 0; j < 8; ++j) { v[j] = __builtin_nontemporal_load(xr + 64 * j); ss += (v[j].x * v[j].x + v[j].y * v[j].y) + (v[j].z * v[j].z + v[j].w * v[j].w); }
            const float rstd = 1.0f / sqrtf(wave_sum(ss) * (1.0f / DM) + EPS);
            u32x2* o8 = (u32x2*)(H + (size_t)(row0 + r) * DM) + lane;
#pragma unroll
            for (int j = 0; j < 8; ++j) { const f32x4 y = v[j] * rstd * gs[j] + sh[j]; u32x2 w; w.x = cvt_pk_bf16(y.x, y.y); w.y = cvt_pk_bf16(y.z, y.w); o8[64 * j] = w; }
        }
    }
}
__device__ __forceinline__ void bias_phase(const bf16_t* W1T, const float* mod, float* cb, int gw, int NGW, int lane) {
    for (int n = gw; n < HID; n += NGW) {
        float w[32];
#pragma unroll
        for (int j = 0; j < 4; ++j) { const u32x4 r = *(const u32x4*)(W1T + (size_t)n * DM + (j * 64 + lane) * 8);
            w[8 * j + 0] = bflo(r.x); w[8 * j + 1] = bfhi(r.x); w[8 * j + 2] = bflo(r.y); w[8 * j + 3] = bfhi(r.y); w[8 * j + 4] = bflo(r.z); w[8 * j + 5] = bfhi(r.z); w[8 * j + 6] = bflo(r.w); w[8 * j + 7] = bfhi(r.w); }
#pragma unroll
        for (int b = 0; b < 4; ++b) { const float* sh = mod + (size_t)b * NMOD + 3 * DM; float s = 0.f;
#pragma unroll
            for (int j = 0; j < 4; ++j) { const f32x4 s0 = *(const f32x4*)(sh + (j * 64 + lane) * 8), s1 = *(const f32x4*)(sh + (j * 64 + lane) * 8 + 4);
                s += (w[8 * j + 0] * s0.x + w[8 * j + 1] * s0.y) + (w[8 * j + 2] * s0.z + w[8 * j + 3] * s0.w) + (w[8 * j + 4] * s1.x + w[8 * j + 5] * s1.y) + (w[8 * j + 6] * s1.z + w[8 * j + 7] * s1.w); }
            s = wave_sum(s);
            if (lane == 0) cb[(size_t)b * HID + n] = s; }
    }
}
typedef float f32x2 __attribute__((ext_vector_type(2)));
typedef short v4i16_t __attribute__((ext_vector_type(4)));
template <bool FULL>
__device__ __forceinline__ void hgrn_seg(int b, int h, int sg, const bf16_t* P, const float* LOGF, const float* __restrict__ ogain, bf16_t* OA, float* SSEG, float* DSEG, LAS unsigned char* lds, int tid) {
    const int lane = tid & 63, wid = __builtin_amdgcn_readfirstlane(tid >> 6), fr = lane & 15, fq = lane >> 4;
    LAS bf16_t* Qd = (LAS bf16_t*)lds;
    LAS bf16_t* Kd = Qd + 64 * 136;
    LAS bf16_t* Qb = Kd + 64 * 136;
    LAS bf16_t* KlT = Qb + 64 * 136;
    LAS bf16_t* VT = KlT + 128 * 72;
    LAS bf16_t* Pm = VT + 128 * 72;
    LAS bf16_t* ST = Pm + 64 * 72;
    LAS float* segtot = (LAS float*)(ST + 128 * 136);
    LAS float* dec = segtot + 1024;
    LAS float* rsq = dec + 128;
    const int unit = (b * 8 + h) * 8 + sg;
    f32x4 sacc[8];
#pragma unroll
    for (int kt = 0; kt < 8; ++kt) sacc[kt] = (f32x4){0.f, 0.f, 0.f, 0.f};
    const int kp = lane, t0 = wid * 8;
    const int tt = wid & 3, vh = wid >> 2;
    f32x4 gn[4];
    if (FULL) {
        for (int j = 0; j < sg; ++j) { const int uj = unit - sg + j;
#pragma unroll
            for (int kt = 0; kt < 8; ++kt) { const f32x4 d = *(const f32x4*)(DSEG + (size_t)uj * 128 + kt * 16 + 4 * fq); const f32x4 sv = *(const f32x4*)(SSEG + ((size_t)uj * 8 + kt) * 2048 + tid * 4); sacc[kt] = sacc[kt] * d + sv; } }
#pragma unroll
        for (int kt = 0; kt < 8; ++kt) { u32x2 w; w.x = cvt_pk_bf16(sacc[kt][0], sacc[kt][1]); w.y = cvt_pk_bf16(sacc[kt][2], sacc[kt][3]);
            *(LAS u32x2*)(ST + (wid * 16 + fr) * 136 + kt * 16 + 4 * fq) = w; }
#pragma unroll
        for (int vt = 0; vt < 4; ++vt) gn[vt] = *(const f32x4*)(ogain + h * 128 + (vh * 4 + vt) * 16 + 4 * fq);
    }
    f32x2 dsum = {0.f, 0.f};
    f32x2 lf[8]; unsigned qv[8], vv[8];
    {   const size_t r0 = (size_t)b * SEQ + (size_t)(sg * 8) * 64;
#pragma unroll
        for (int j = 0; j < 8; ++j) { const size_t row = r0 + t0 + j; lf[j] = *(const f32x2*)(LOGF + row * 1024 + h * 128 + 2 * kp); vv[j] = *(const unsigned*)(P + row * PLD + 1024 + h * 128 + 2 * kp); if (FULL) qv[j] = *(const unsigned*)(P + row * PLD + h * 128 + 2 * kp); } }
    LBAR();
    for (int n = 0; n < 8; ++n) {
        const size_t r0 = (size_t)b * SEQ + (size_t)(sg * 8 + n) * 64;
        f32x2 cs[8];
        { f32x2 a = {0.f, 0.f};
#pragma unroll
          for (int j = 0; j < 8; ++j) { a += lf[j]; cs[j] = a; } }
        *(LAS f32x2*)(segtot + wid * 128 + 2 * kp) = cs[7];
        u32x2 gg[4];
        if (FULL) {
#pragma unroll
            for (int vt = 0; vt < 4; ++vt) gg[vt] = *(const u32x2*)(P + (r0 + tt * 16 + fr) * PLD + 2048 + h * 128 + (vh * 4 + vt) * 16 + 4 * fq);
        }
        LBAR();
        f32x2 off = {0.f, 0.f}, bmid = {0.f, 0.f}, blast = {0.f, 0.f};
#pragma unroll
        for (int s8 = 0; s8 < 8; ++s8) { const f32x2 tv = *(const LAS f32x2*)(segtot + s8 * 128 + 2 * kp); if (s8 < wid) off += tv; if (s8 < 4) bmid += tv; blast += tv; }
        dsum += blast;
        f32x2 emid, elm;
        emid.x = __expf(bmid.x); emid.y = __expf(bmid.y); elm.x = __expf(blast.x - bmid.x); elm.y = __expf(blast.y - bmid.y);
        float kl0[8], kl1[8];
#pragma unroll
        for (int j = 0; j < 8; ++j) { const f32x2 bb = cs[j] + off;
            const float f0 = __expf(lf[j].x), f1 = __expf(lf[j].y), kk0 = 1.0f - f0, kk1 = 1.0f - f1;
            const float e0 = __expf(bb.x - bmid.x), e1 = __expf(bb.y - bmid.y), i0 = __expf(bmid.x - bb.x), i1 = __expf(bmid.y - bb.y);
            if (FULL) { const float q0 = bflo(qv[j]), q1 = bfhi(qv[j]);
                *(LAS unsigned*)(Qd + (t0 + j) * 136 + 2 * kp) = cvt_pk_bf16(q0 * e0, q1 * e1);
                *(LAS unsigned*)(Kd + (t0 + j) * 136 + 2 * kp) = cvt_pk_bf16(kk0 * i0, kk1 * i1);
                *(LAS unsigned*)(Qb + (t0 + j) * 136 + 2 * kp) = cvt_pk_bf16(q0 * e0 * emid.x, q1 * e1 * emid.y); }
            kl0[j] = kk0 * i0 * elm.x; kl1[j] = kk1 * i1 * elm.y; }
        { u32x4 w0, w1; w0.x = cvt_pk_bf16(kl0[0], kl0[1]); w0.y = cvt_pk_bf16(kl0[2], kl0[3]); w0.z = cvt_pk_bf16(kl0[4], kl0[5]); w0.w = cvt_pk_bf16(kl0[6], kl0[7]);
          w1.x = cvt_pk_bf16(kl1[0], kl1[1]); w1.y = cvt_pk_bf16(kl1[2], kl1[3]); w1.z = cvt_pk_bf16(kl1[4], kl1[5]); w1.w = cvt_pk_bf16(kl1[6], kl1[7]);
          *(LAS u32x4*)(KlT + (2 * kp) * 72 + t0) = w0; *(LAS u32x4*)(KlT + (2 * kp + 1) * 72 + t0) = w1;
          u32x4 v0, v1;
          v0.x = (vv[0] & 0xffffu) | (vv[1] << 16); v0.y = (vv[2] & 0xffffu) | (vv[3] << 16); v0.z = (vv[4] & 0xffffu) | (vv[5] << 16); v0.w = (vv[6] & 0xffffu) | (vv[7] << 16);
          v1.x = (vv[0] >> 16) | (vv[1] & 0xffff0000u); v1.y = (vv[2] >> 16) | (vv[3] & 0xffff0000u); v1.z = (vv[4] >> 16) | (vv[5] & 0xffff0000u); v1.w = (vv[6] >> 16) | (vv[7] & 0xffff0000u);
          *(LAS u32x4*)(VT + (2 * kp) * 72 + t0) = v0; *(LAS u32x4*)(VT + (2 * kp + 1) * 72 + t0) = v1; }
        if (wid == 0) { f32x2 dv; dv.x = __expf(blast.x); dv.y = __expf(blast.y); *(LAS f32x2*)(dec + 2 * kp) = dv; }
        if (n + 1 < 8) {
            const size_t r1 = r0 + 64;
#pragma unroll
            for (int j = 0; j < 8; ++j) { const size_t row = r1 + t0 + j; lf[j] = *(const f32x2*)(LOGF + row * 1024 + h * 128 + 2 * kp); vv[j] = *(const unsigned*)(P + row * PLD + 1024 + h * 128 + 2 * kp); if (FULL) qv[j] = *(const unsigned*)(P + row * PLD + h * 128 + 2 * kp); }
        }
        LBAR();
        f32x4 o[4];
        if (FULL) {
#pragma unroll
            for (int q = 0; q < 2; ++q) { const int id = wid * 2 + q, t2 = id >> 2, st = id & 3;
                f32x4 acc = {0.f, 0.f, 0.f, 0.f};
                if (st <= t2) {
#pragma unroll
                    for (int ks = 0; ks < 4; ++ks) acc = MFMA16(ldfrag(Kd, 136, st * 16 + fr, ks * 32 + 8 * fq), ldfrag(Qd, 136, t2 * 16 + fr, ks * 32 + 8 * fq), acc);
                }
                const int t = t2 * 16 + fr, s0 = st * 16 + 4 * fq;
                u32x2 w; w.x = cvt_pk_bf16(s0 + 0 <= t ? acc[0] : 0.f, s0 + 1 <= t ? acc[1] : 0.f); w.y = cvt_pk_bf16(s0 + 2 <= t ? acc[2] : 0.f, s0 + 3 <= t ? acc[3] : 0.f);
                *(LAS u32x2*)(Pm + t * 72 + s0) = w; }
            LBAR();
            float ss = 0.f;
#pragma unroll
            for (int vt = 0; vt < 4; ++vt) { const int vrow = (vh * 4 + vt) * 16 + fr; f32x4 acc = {0.f, 0.f, 0.f, 0.f};
#pragma unroll
                for (int ks = 0; ks < 2; ++ks) acc = MFMA16(ldfrag(VT, 72, vrow, ks * 32 + 8 * fq), ldfrag(Pm, 72, tt * 16 + fr, ks * 32 + 8 * fq), acc);
#pragma unroll
                for (int ks = 0; ks < 4; ++ks) acc = MFMA16(ldfrag(ST, 136, vrow, ks * 32 + 8 * fq), ldfrag(Qb, 136, tt * 16 + fr, ks * 32 + 8 * fq), acc);
                o[vt] = acc; ss += (acc[0] * acc[0] + acc[1] * acc[1]) + (acc[2] * acc[2] + acc[3] * acc[3]); }
            ss += __shfl_xor(ss, 16); ss += __shfl_xor(ss, 32);
            if (fq == 0) rsq[vh * 64 + tt * 16 + fr] = ss;
        }
#pragma unroll
        for (int kt = 0; kt < 8; ++kt) { const f32x4 d = *(const LAS f32x4*)(dec + kt * 16 + 4 * fq); f32x4 acc = sacc[kt] * d;
#pragma unroll
            for (int ks = 0; ks < 2; ++ks) acc = MFMA16(ldfrag(KlT, 72, kt * 16 + fr, ks * 32 + 8 * fq), ldfrag(VT, 72, wid * 16 + fr, ks * 32 + 8 * fq), acc);
            sacc[kt] = acc; }
        LBAR();
        if (FULL) {
            { const int t = tt * 16 + fr; const float rstd = 1.0f / sqrtf((rsq[t] + rsq[64 + t]) * (1.0f / 128.0f) + EPS); const size_t row = r0 + t;
#pragma unroll
              for (int vt = 0; vt < 4; ++vt) { const int v0 = h * 128 + (vh * 4 + vt) * 16 + 4 * fq; const u32x2 g = gg[vt];
                  u32x2 w; w.x = cvt_pk_bf16(o[vt][0] * rstd * gn[vt].x * bflo(g.x), o[vt][1] * rstd * gn[vt].y * bfhi(g.x)); w.y = cvt_pk_bf16(o[vt][2] * rstd * gn[vt].z * bflo(g.y), o[vt][3] * rstd * gn[vt].w * bfhi(g.y));
                  *(u32x2*)(OA + row * 1024 + v0) = w; } }
            if (n + 1 < 8) {
#pragma unroll
                for (int kt = 0; kt < 8; ++kt) { u32x2 w; w.x = cvt_pk_bf16(sacc[kt][0], sacc[kt][1]); w.y = cvt_pk_bf16(sacc[kt][2], sacc[kt][3]);
                    *(LAS u32x2*)(ST + (wid * 16 + fr) * 136 + kt * 16 + 4 * fq) = w; }
            }
        }
    }
    if (!FULL) {
#pragma unroll
        for (int kt = 0; kt < 8; ++kt) *(f32x4*)(SSEG + ((size_t)unit * 8 + kt) * 2048 + tid * 4) = sacc[kt];
        if (wid == 0) { f32x2 dv; dv.x = __expf(dsum.x); dv.y = __expf(dsum.y); *(f32x2*)(DSEG + (size_t)unit * 128 + 2 * kp) = dv; }
    }
    LBAR();
}
__device__ __forceinline__ void hgrn_state(int b, int h, int sg, const bf16_t* P, const float* LOGF, float* SSEG, float* DSEG, LAS unsigned char* lds, int tid) {
    const int lane = tid & 63, wid = __builtin_amdgcn_readfirstlane(tid >> 6), fr = lane & 15, fq = lane >> 4;
    LAS bf16_t* KlT = (LAS bf16_t*)lds;
    LAS bf16_t* VT = KlT + 128 * 136;
    LAS float* segtot = (LAS float*)(VT + 128 * 136);
    const int unit = (b * 8 + h) * 8 + sg, kp = lane, t0 = wid * 16;
    f32x4 sacc[8];
#pragma unroll
    for (int kt = 0; kt < 8; ++kt) sacc[kt] = (f32x4){0.f, 0.f, 0.f, 0.f};
    f32x2 carry = {0.f, 0.f};
    f32x2 lf[16]; unsigned vv[16];
    const size_t rseg = (size_t)b * SEQ + (size_t)sg * 512;
#pragma unroll
    for (int j = 0; j < 16; ++j) { const size_t row = rseg + 384 + t0 + j; lf[j] = *(const f32x2*)(LOGF + row * 1024 + h * 128 + 2 * kp); vv[j] = *(const unsigned*)(P + row * PLD + 1024 + h * 128 + 2 * kp); }
    for (int sb = 3; sb >= 0; --sb) {
        f32x2 suf[16];
        { f32x2 a = {0.f, 0.f};
#pragma unroll
          for (int j = 15; j >= 0; --j) { suf[j] = a; a += lf[j]; }
          *(LAS f32x2*)(segtot + wid * 128 + 2 * kp) = a; }
        LBAR();
        f32x2 after = carry, sub = {0.f, 0.f};
#pragma unroll
        for (int w = 0; w < 8; ++w) { const f32x2 tv = *(const LAS f32x2*)(segtot + w * 128 + 2 * kp); if (w > wid) after += tv; sub += tv; }
        carry += sub;
        float kl0[16], kl1[16];
#pragma unroll
        for (int j = 0; j < 16; ++j) { const f32x2 e = suf[j] + after; kl0[j] = (1.0f - __expf(lf[j].x)) * __expf(e.x); kl1[j] = (1.0f - __expf(lf[j].y)) * __expf(e.y); }
#pragma unroll
        for (int q = 0; q < 2; ++q) { u32x4 w0, w1, v0, v1;
            w0.x = cvt_pk_bf16(kl0[8 * q + 0], kl0[8 * q + 1]); w0.y = cvt_pk_bf16(kl0[8 * q + 2], kl0[8 * q + 3]); w0.z = cvt_pk_bf16(kl0[8 * q + 4], kl0[8 * q + 5]); w0.w = cvt_pk_bf16(kl0[8 * q + 6], kl0[8 * q + 7]);
            w1.x = cvt_pk_bf16(kl1[8 * q + 0], kl1[8 * q + 1]); w1.y = cvt_pk_bf16(kl1[8 * q + 2], kl1[8 * q + 3]); w1.z = cvt_pk_bf16(kl1[8 * q + 4], kl1[8 * q + 5]); w1.w = cvt_pk_bf16(kl1[8 * q + 6], kl1[8 * q + 7]);
            *(LAS u32x4*)(KlT + (2 * kp) * 136 + t0 + 8 * q) = w0; *(LAS u32x4*)(KlT + (2 * kp + 1) * 136 + t0 + 8 * q) = w1;
            v0.x = (vv[8 * q + 0] & 0xffffu) | (vv[8 * q + 1] << 16); v0.y = (vv[8 * q + 2] & 0xffffu) | (vv[8 * q + 3] << 16); v0.z = (vv[8 * q + 4] & 0xffffu) | (vv[8 * q + 5] << 16); v0.w = (vv[8 * q + 6] & 0xffffu) | (vv[8 * q + 7] << 16);
            v1.x = (vv[8 * q + 0] >> 16) | (vv[8 * q + 1] & 0xffff0000u); v1.y = (vv[8 * q + 2] >> 16) | (vv[8 * q + 3] & 0xffff0000u); v1.z = (vv[8 * q + 4] >> 16) | (vv[8 * q + 5] & 0xffff0000u); v1.w = (vv[8 * q + 6] >> 16) | (vv[8 * q + 7] & 0xffff0000u);
            *(LAS u32x4*)(VT + (2 * kp) * 136 + t0 + 8 * q) = v0; *(LAS u32x4*)(VT + (2 * kp + 1) * 136 + t0 + 8 * q) = v1; }
        if (sb > 0) {
#pragma unroll
            for (int j = 0; j < 16; ++j) { const size_t row = rseg + (size_t)(sb - 1) * 128 + t0 + j; lf[j] = *(const f32x2*)(LOGF + row * 1024 + h * 128 + 2 * kp); vv[j] = *(const unsigned*)(P + row * PLD + 1024 + h * 128 + 2 * kp); }
        }
        LBAR();
        bf16x8 vf[4];
#pragma unroll
        for (int ks = 0; ks < 4; ++ks) vf[ks] = ldfrag(VT, 136, wid * 16 + fr, ks * 32 + 8 * fq);
#pragma unroll
        for (int kt = 0; kt < 8; ++kt) { f32x4 acc = sacc[kt];
#pragma unroll
            for (int ks = 0; ks < 4; ++ks) acc = MFMA16(ldfrag(KlT, 136, kt * 16 + fr, ks * 32 + 8 * fq), vf[ks], acc);
            sacc[kt] = acc; }
        LBAR();
    }
#pragma unroll
    for (int kt = 0; kt < 8; ++kt) *(f32x4*)(SSEG + ((size_t)unit * 8 + kt) * 2048 + tid * 4) = sacc[kt];
    if (wid == 0) { f32x2 dv; dv.x = __expf(carry.x); dv.y = __expf(carry.y); *(f32x2*)(DSEG + (size_t)unit * 128 + 2 * kp) = dv; }
}
struct SwaRaw { u32x4 k[4], v[4], q[2]; };
__device__ __forceinline__ void swa_load(SwaRaw& R, int b, int kvh, int nb, const bf16_t* P, int tid) {
    const size_t rq0 = (size_t)b * SEQ + (size_t)nb * 128; const int ch = tid & 7;
#pragma unroll
    for (int p = 0; p < 4; ++p) { const int ki = (tid >> 3) + 64 * p; const bool valid = (nb > 0) || (ki >= 128);
        R.k[p] = (u32x4){0u, 0u, 0u, 0u}; R.v[p] = (u32x4){0u, 0u, 0u, 0u};
        if (valid) { const size_t row = rq0 - 128 + ki; R.k[p] = *(const u32x4*)(P + row * PLD + 4096 + kvh * 64 + ch * 8); R.v[p] = *(const u32x4*)(P + row * PLD + 4352 + kvh * 64 + ch * 8); } }
#pragma unroll
    for (int p = 0; p < 2; ++p) R.q[p] = *(const u32x4*)(P + (rq0 + (tid >> 3) + 64 * p) * PLD + 3072 + (kvh * 4) * 64 + ch * 8);
}
__device__ __forceinline__ void swa_compute(SwaRaw& R, int b, int kvh, int nb, const bf16_t* P, const float* __restrict__ qg, const float* __restrict__ kg, const float* __restrict__ sinks, bf16_t* OB, LAS unsigned char* lds, int tid) {
    const int lane = tid & 63, wid = __builtin_amdgcn_readfirstlane(tid >> 6), fr = lane & 15, fq = lane >> 4;
    LAS bf16_t* Qs = (LAS bf16_t*)lds;
    LAS bf16_t* Ks = Qs + 128 * 72;
    LAS bf16_t* Vr = Ks + 256 * 72;
    LAS bf16_t* Pw = Vr + 256 * 72 + wid * (16 * 168);
    const size_t rq0 = (size_t)b * SEQ + (size_t)nb * 128;
    const int ch = tid & 7;
    {
        const f32x4 g0 = *(const f32x4*)(kg + ch * 8), g1 = *(const f32x4*)(kg + ch * 8 + 4);
#pragma unroll
        for (int p = 0; p < 4; ++p) { const int ki = (tid >> 3) + 64 * p; const u32x4 raw = R.k[p], rv = R.v[p];
            float x[8] = {bflo(raw.x), bfhi(raw.x), bflo(raw.y), bfhi(raw.y), bflo(raw.z), bfhi(raw.z), bflo(raw.w), bfhi(raw.w)};
            float ss = 0.f;
#pragma unroll
            for (int e = 0; e < 8; ++e) ss += x[e] * x[e];
            ss += __shfl_xor(ss, 1); ss += __shfl_xor(ss, 2); ss += __shfl_xor(ss, 4);
            const float rs = 1.0f / sqrtf(ss * (1.0f / 64.0f) + EPS);
            u32x4 w; w.x = cvt_pk_bf16(x[0] * rs * g0.x, x[1] * rs * g0.y); w.y = cvt_pk_bf16(x[2] * rs * g0.z, x[3] * rs * g0.w); w.z = cvt_pk_bf16(x[4] * rs * g1.x, x[5] * rs * g1.y); w.w = cvt_pk_bf16(x[6] * rs * g1.z, x[7] * rs * g1.w);
            *(LAS u32x4*)(Ks + ki * 72 + ch * 8) = w;
            *(LAS u32x4*)(Vr + ki * 72 + ch * 8) = rv; }
    }
    const f32x4 qg0 = *(const f32x4*)(qg + ch * 8), qg1 = *(const f32x4*)(qg + ch * 8 + 4);
    const int kt0 = wid > 0 ? wid - 1 : 0;
    for (int g = 0; g < 4; ++g) {
        const int hq = kvh * 4 + g;
#pragma unroll
        for (int p = 0; p < 2; ++p) { const int row = (tid >> 3) + 64 * p; const u32x4 raw = R.q[p];
            float x[8] = {bflo(raw.x), bfhi(raw.x), bflo(raw.y), bfhi(raw.y), bflo(raw.z), bfhi(raw.z), bflo(raw.w), bfhi(raw.w)};
            float ss = 0.f;
#pragma unroll
            for (int e = 0; e < 8; ++e) ss += x[e] * x[e];
            ss += __shfl_xor(ss, 1); ss += __shfl_xor(ss, 2); ss += __shfl_xor(ss, 4);
            const float rs = 0.125f / sqrtf(ss * (1.0f / 64.0f) + EPS);
            u32x4 w; w.x = cvt_pk_bf16(x[0] * rs * qg0.x, x[1] * rs * qg0.y); w.y = cvt_pk_bf16(x[2] * rs * qg0.z, x[3] * rs * qg0.w); w.z = cvt_pk_bf16(x[4] * rs * qg1.x, x[5] * rs * qg1.y); w.w = cvt_pk_bf16(x[6] * rs * qg1.z, x[7] * rs * qg1.w);
            *(LAS u32x4*)(Qs + row * 72 + ch * 8) = w; }
        if (g < 3) {
#pragma unroll
            for (int p = 0; p < 2; ++p) R.q[p] = *(const u32x4*)(P + (rq0 + (tid >> 3) + 64 * p) * PLD + 3072 + (hq + 1) * 64 + ch * 8);
        }
        LBAR();
        f32x4 s[10];
#pragma unroll
        for (int j = 0; j < 10; ++j) { f32x4 acc = {0.f, 0.f, 0.f, 0.f};
#pragma unroll
            for (int ks = 0; ks < 2; ++ks) acc = MFMA16(ldfrag(Ks, 72, (kt0 + j) * 16 + fr, ks * 32 + 8 * fq), ldfrag(Qs, 72, wid * 16 + fr, ks * 32 + 8 * fq), acc);
            s[j] = acc; }
        const int qi = wid * 16 + fr; const float sink = sinks[hq]; float m = sink;
#pragma unroll
        for (int j = 0; j < 10; ++j)
#pragma unroll
            for (int r = 0; r < 4; ++r) { const int ki = (kt0 + j) * 16 + 4 * fq + r; const bool valid = (ki > qi) && (ki <= qi + 128) && ((nb > 0) || (ki >= 128));
                s[j][r] = valid ? s[j][r] : -INFINITY; m = fmaxf(m, s[j][r]); }
        m = fmaxf(m, __shfl_xor(m, 16)); m = fmaxf(m, __shfl_xor(m, 32));
        float sum = 0.f;
#pragma unroll
        for (int j = 0; j < 10; ++j) {
#pragma unroll
            for (int r = 0; r < 4; ++r) { s[j][r] = __expf(s[j][r] - m); sum += s[j][r]; }
            u32x2 w; w.x = cvt_pk_bf16(s[j][0], s[j][1]); w.y = cvt_pk_bf16(s[j][2], s[j][3]);
            *(LAS u32x2*)(Pw + fr * 168 + j * 16 + 4 * fq) = w; }
        sum += __shfl_xor(sum, 16); sum += __shfl_xor(sum, 32);
        const float inv = 1.0f / (sum + __expf(sink - m));
        asm volatile("s_waitcnt lgkmcnt(0)" ::: "memory"); __builtin_amdgcn_wave_barrier();
#pragma unroll
        for (int dt = 0; dt < 4; ++dt) { f32x4 acc = {0.f, 0.f, 0.f, 0.f};
#pragma unroll
            for (int ks = 0; ks < 5; ++ks) { const LAS bf16_t* vp = Vr + (kt0 * 16 + ks * 32 + 8 * fq + (fr >> 2)) * 72 + dt * 16 + 4 * (fr & 3);
                const v4i16_t lo = __builtin_amdgcn_ds_read_tr16_b64_v4i16((LAS v4i16_t*)vp), hi = __builtin_amdgcn_ds_read_tr16_b64_v4i16((LAS v4i16_t*)(vp + 4 * 72));
                const bf16x8 vf = {lo[0], lo[1], lo[2], lo[3], hi[0], hi[1], hi[2], hi[3]};
                acc = MFMA16(vf, ldfrag(Pw, 168, fr, ks * 32 + 8 * fq), acc); }
            u32x2 w; w.x = cvt_pk_bf16(acc[0] * inv, acc[1] * inv); w.y = cvt_pk_bf16(acc[2] * inv, acc[3] * inv);
            *(u32x2*)(OB + (rq0 + qi) * 1024 + hq * 64 + dt * 16 + 4 * fq) = w; }
        LBAR();
    }
}

struct Args { const float* in[17]; float* out; unsigned char* ws; };
__global__ void __launch_bounds__(NTHR, 2) fwd_megakernel(Args a) {
    extern __shared__ __attribute__((aligned(16))) unsigned char lds_raw[];
    cg::grid_group grid = cg::this_grid();
    LAS unsigned char* lds = (LAS unsigned char*)lds_raw;
    const int tid = threadIdx.x, lane = tid & 63, wave = __builtin_amdgcn_readfirstlane(tid >> 6);
    const int G = gridDim.x, blk = blockIdx.x;
    const int vcu = (G % 8 == 0) ? (blk % 8) * (G / 8) + blk / 8 : blk;
    const int gw = vcu * 8 + wave, NGW = G * 8;
    const float *x = a.in[0], *cvec = a.in[1], *w_ada = a.in[2], *b_ada = a.in[3], *g1 = a.in[4], *w_in = a.in[5], *lbl = a.in[6], *ogain = a.in[7], *qg = a.in[8], *kg = a.in[9], *sinks = a.in[10],
                *w_a = a.in[11], *w_b = a.in[12], *w_o = a.in[13], *g2 = a.in[14], *w1 = a.in[15], *w2 = a.in[16];
    unsigned char* ws = a.ws;
    float* mod = (float*)(ws + WS_MOD);
    bf16_t *WinT = (bf16_t*)(ws + WS_WIN), *WabT = (bf16_t*)(ws + WS_WAB), *WoT = (bf16_t*)(ws + WS_WO), *W1T = (bf16_t*)(ws + WS_W1), *W2T = (bf16_t*)(ws + WS_W2);
    bf16_t *H = (bf16_t*)(ws + WS_H), *P = (bf16_t*)(ws + WS_P), *U = (bf16_t*)(ws + WS_P);
    float* out = a.out;
    float* LOGF = out;
    bf16_t* OAB = (bf16_t*)(out + (size_t)M * 1024);
    float* SSEG = (float*)(ws + WS_SSEG); float* DSEG = (float*)(ws + WS_DSEG);
    bf16_t* H2 = (bf16_t*)(ws + WS_H2); float* cb = (float*)(ws + WS_CB); float* part = (float*)(ws + WS_PART);
    volatile LAS unsigned* MISC = (volatile LAS unsigned*)(lds + MISC_OFF);
    if (tid < 16) MISC[tid] = 0u;
    __syncthreads();
    XcdBarrier bar = xcd_barrier_post((unsigned*)(ws + WS_BAR), MISC + 8);
#define GRID_SYNC() xcd_barrier(bar)
    if (a.ws == nullptr) grid.sync();

    for (int it = blk; it < NMOD / 48; it += G) gemv_item(cvec, w_ada, b_ada, mod, lds, it, tid);
    LAS float* scr = (LAS float*)(lds + wave * 16640);
    constexpr int I_IN = (DM / 64) * (INW / 64), I_A = (1024 / 64) * (DM / 64), I_O = (DM / 64) * (DM / 64), I_1 = (DM / 64) * (HID / 64), I_2 = (HID / 64) * (DM / 64);
    constexpr int NP0 = I_IN + 2 * I_A + I_O, NITEMS = NP0 + I_1 + I_2;
    {
#define TR_DECODE(it_, d_) do { int r_ = (it_); \
            if (r_ < I_IN) { d_ = TrDesc{w_in, WinT, DM, INW, 0, r_}; break; } r_ -= I_IN; \
            if (r_ < I_A) { d_ = TrDesc{w_b, WabT, 1024, DM, 0, r_}; break; } r_ -= I_A; \
            if (r_ < I_A) { d_ = TrDesc{w_a, WabT, 1024, DM, DM, r_}; break; } r_ -= I_A; \
            if (r_ < I_O) { d_ = TrDesc{w_o, WoT, DM, DM, 0, r_}; break; } r_ -= I_O; \
            if (r_ < I_1) { d_ = TrDesc{w1, W1T, DM, HID, 0, r_}; break; } r_ -= I_1; \
            d_ = TrDesc{w2, W2T, HID, DM, 0, r_}; } while (0)
#define TR_RUN(first_, stride_, hi_) do { int it = (first_); \
        if (it < (hi_)) { f32x4 va[16], vb[16]; TrDesc da, db; TR_DECODE(it, da); tr_load(da, lane, va); \
            for (;;) { const int it2 = it + (stride_); const bool h2 = it2 < (hi_); \
                if (h2) { TR_DECODE(it2, db); tr_load(db, lane, vb); } \
                tr_store(da, lane, va, scr); if (!h2) break; \
                const int it3 = it2 + (stride_); const bool h3 = it3 < (hi_); \
                if (h3) { TR_DECODE(it3, da); tr_load(da, lane, va); } \
                tr_store(db, lane, vb, scr); if (!h3) break; it = it3; } } } while (0)
        TR_RUN(gw, NGW, NP0);
    }
    GRID_SYNC();
    norm_phase(x, g1, mod, 0, DM, H, gw, NGW, lane);
    GRID_SYNC();
    {
        pg8::Gemm g{H, WinT, M, INW, DM}; pg8::InOrder S; S.base.init(M, INW, G, blk);
        pg8::EpiIn E{P, LOGF, lbl};
        pg8::gemm_phase<pg8::EpiIn, pg8::InOrder, true, true>(lds, g, S, E);
    }
    {
        constexpr int nwg = (M / 256) * (INW / 256);
        const int maxu = (nwg + G - 1) / G, first_idle = nwg - (maxu - 1) * G, n_idle = first_idle < G ? G - first_idle : 0;
        if (n_idle > 0) { if (blk >= first_idle) TR_RUN(NP0 + (blk - first_idle) * 8 + wave, n_idle * 8, NITEMS); }
        else TR_RUN(NP0 + gw, NGW, NITEMS);
    }
    GRID_SYNC();
    for (int u = blk; u < 256; u += G) { SwaRaw R; swa_load(R, u >> 7, (u >> 5) & 3, u & 31, P, tid);
        hgrn_state(u >> 6, (u >> 3) & 7, u & 7, P, LOGF, SSEG, DSEG, lds, tid);
        swa_compute(R, u >> 7, (u >> 5) & 3, u & 31, P, qg, kg, sinks, OAB, lds, tid); }
    if (G == 256) bias_phase(W1T, mod, cb, gw, NGW, lane);
    GRID_SYNC();
    for (int u = blk; u < 256; u += G) { const int us = 256 + u;
        hgrn_seg<true>(u >> 6, (u >> 3) & 7, u & 7, P, LOGF, ogain, OAB + (size_t)M * 1024, SSEG, DSEG, lds, tid);
        SwaRaw R; swa_load(R, us >> 7, (us >> 5) & 3, us & 31, P, tid);
        swa_compute(R, us >> 7, (us >> 5) & 3, us & 31, P, qg, kg, sinks, OAB, lds, tid); }
    GRID_SYNC();
    {
        pg8::Gemm g{OAB, WabT, 2 * M, 2 * DM, 1024}; pg8::PairOrder S; S.base.init(M, DM, G, blk);
        pg8::EpiMerge E{P, H};
        pg8::gemm_phase<pg8::EpiMerge, pg8::PairOrder, true, true>(lds, g, S, E);
    }
    GRID_SYNC();
    if (G == 256) {
    {
        pg8::Gemm g{H, WoT, M, DM, DM}; pg8::StaticOrderW<4> S; S.init(M, DM, G, blk);
        pg8::EpiRes3 E{x, out, mod, g2, H2, part};
        pg8::gemm_phase<pg8::EpiRes3, pg8::StaticOrderW<4>, true, true>(lds, g, S, E);
    }
    GRID_SYNC();
    {
        pg8::Gemm g{H2, W1T, M, HID, DM}; pg8::StaticOrderW<4> S; S.init(M, HID, G, blk);
        pg8::Unit u0; S.next(0, u0);
        LAS float* rstd = (LAS float*)(lds + 131072 + 1024);
        { const int row = ((u0.pm & ~4) | ((tid >> 8) << 2)) * 256 + (tid & 255); float sacc = 0.f;
#pragma unroll 8
          for (int j = 0; j < 32; ++j) sacc += part[(size_t)j * 16384 + row];
          rstd[tid] = 1.0f / sqrtf(sacc * (1.0f / DM) + EPS); }
        __syncthreads();
        pg8::EpiUp2 E{U, HID, rstd, cb};
        pg8::gemm_phase<pg8::EpiUp2, pg8::StaticOrderW<4>, true, true>(lds, g, S, E);
    }
    GRID_SYNC();
    } else {
    {
        pg8::Gemm g{H, WoT, M, DM, DM}; pg8::StaticOrder S; S.init(M, DM, G, blk);
        pg8::EpiRes E{x, out, mod + 2 * DM};
        pg8::gemm_phase<pg8::EpiRes, pg8::StaticOrder, true, true>(lds, g, S, E);
    }
    GRID_SYNC();
    norm_phase(out, g2, mod, 3 * DM, 4 * DM, H, gw, NGW, lane);
    GRID_SYNC();
    {
        pg8::Gemm g{H, W1T, M, HID, DM}; pg8::StaticOrder S; S.init(M, HID, G, blk);
        pg8::EpiRelu2 E{U, HID};
        pg8::gemm_phase<pg8::EpiRelu2, pg8::StaticOrder, true, true>(lds, g, S, E);
    }
    GRID_SYNC();
    }
    {
        pg8::Gemm g{U, W2T, M, DM, HID}; pg8::StaticOrderW<4> S; S.init(M, DM, G, blk);
        pg8::EpiRes E{out, out, mod + 5 * DM};
        pg8::gemm_phase<pg8::EpiRes, pg8::StaticOrderW<4>, true, true>(lds, g, S, E);
    }
}

extern "C" void kernel_launch(void* const* d_in, const int* in_sizes, int n_in, void* d_out, int out_size, void* d_ws, size_t ws_size, hipStream_t stream) {
    static int grid_blocks = 0;
    if (grid_blocks == 0) {
        if (n_in != 17 || out_size != M * DM || ws_size < WS_END) { fprintf(stderr, "kernel_launch: unexpected shapes (n_in %d out %d ws %zu)\n", n_in, out_size, ws_size); grid_blocks = -1; return; }
        int dev = 0, cus = 0, per_cu = 0;
        (void)hipGetDevice(&dev);
        (void)hipDeviceGetAttribute(&cus, hipDeviceAttributeMultiprocessorCount, dev);
        if (hipFuncSetAttribute((const void*)fwd_megakernel, hipFuncAttributeMaxDynamicSharedMemorySize, LDS_BYTES) != hipSuccess) { fprintf(stderr, "kernel_launch: hipFuncSetAttribute failed\n"); grid_blocks = -1; return; }
        if (hipOccupancyMaxActiveBlocksPerMultiprocessor(&per_cu, (const void*)fwd_megakernel, NTHR, LDS_BYTES) != hipSuccess || per_cu < 1) { fprintf(stderr, "kernel_launch: occupancy query says %d\n", per_cu); (void)hipGetLastError(); grid_blocks = -1; return; }
        grid_blocks = cus;
        fprintf(stderr, "kernel_launch: %d CUs, %d blocks/CU by occupancy, launching %d blocks\n", cus, per_cu, grid_blocks);
    }
    if (grid_blocks < 0) return;
    if (hipMemsetAsync((char*)d_ws + WS_BAR, 0, ZERO_BYTES, stream) != hipSuccess) { fprintf(stderr, "kernel_launch: memset failed\n"); return; }
    Args a{};
    for (int i = 0; i < 17; ++i) a.in[i] = (const float*)d_in[i];
    a.out = (float*)d_out; a.ws = (unsigned char*)d_ws;
    void* args[] = {&a};
    hipError_t e = hipLaunchCooperativeKernel((const void*)fwd_megakernel, dim3(grid_blocks), dim3(NTHR), args, LDS_BYTES, stream);
    if (e != hipSuccess) fprintf(stderr, "cooperative launch failed: %s (grid %d)\n", hipGetErrorString(e), grid_blocks);
}
```

```cpp
#include <hip/hip_runtime.h>
#include <hip/hip_cooperative_groups.h>
#include <cstdio>
#include <cstdint>
namespace cg = cooperative_groups;
namespace pg8 {
#define PG8_LAS __attribute__((address_space(3)))
typedef unsigned short bf16_t;
typedef short bf16x8 __attribute__((ext_vector_type(8)));
typedef float f32x4 __attribute__((ext_vector_type(4)));
typedef unsigned u32x4 __attribute__((ext_vector_type(4)));
constexpr int BM = 256, BK = 64, HALF = 128, HTB = HALF * BK * 2  , STAGE_BYTES = 8 * HTB, NXCD = 8, WGM = 8;

__host__ __device__ __forceinline__ int lds_byte(int r, int c) { const int st = (r >> 4) * 2 + (c >> 5), rr = r & 15, cc = c & 31, ob = rr * 64 + cc * 2; return st * 1024 + (ob ^ (((ob >> 9) & 1) << 5)); }
__host__ __device__ __forceinline__ void stage_rc(int b, int& R, int& C) { const int st = b / 1024, sb = b % 1024, swz = sb ^ (((sb >> 9) & 1) << 5); R = (st >> 1) * 16 + swz / 64; C = (st & 1) * 32 + (swz % 64) / 2; }
__host__ __device__ __forceinline__ int perm32(int rho) { const int n = rho >> 4, i = rho & 15; return 8 * (i >> 2) + 4 * n + (i & 3); }

struct Unit { int pm, pn; };
struct Gemm { const bf16_t* A; const bf16_t* Bt; int M, N, K; };

struct StaticOrder {
    int nM, nN, nwg, G, c;
    __host__ __device__ void init(int M, int N, int G_, int c_) { nM = M / BM; nN = N / BM; nwg = nM * nN; G = G_; c = c_; }
    __host__ __device__ bool next(int i, Unit& u) const {
        const long L = (long)i * G + c; if (L >= nwg) return false;
        int wgid = (int)L; { const int q = nwg / NXCD, r = nwg % NXCD, xcd = wgid % NXCD, off = wgid / NXCD; wgid = (xcd < r ? xcd * (q + 1) : r * (q + 1) + (xcd - r) * q) + off; }
        const int nig = WGM * nN, gid = wgid / nig, fm = gid * WGM, gsz = (nM - fm) < WGM ? (nM - fm) : WGM;
        u.pm = fm + ((wgid % nig) % gsz); u.pn = (wgid % nig) / gsz; return true;
    }
    __device__ __forceinline__ void a_ready(const Unit&) const {}
    __device__ __forceinline__ void done(const Unit&) const {}
};

__device__ __forceinline__ unsigned cvt_pk_bf16(float lo, float hi) { unsigned r; asm volatile("v_cvt_pk_bf16_f32 %0, %1, %2" : "=v"(r) : "v"(lo), "v"(hi)); return r; }
typedef float f32x2 __attribute__((ext_vector_type(2)));
typedef unsigned u32x2 __attribute__((ext_vector_type(2)));
__device__ __forceinline__ float bf2f(unsigned short h) { return __uint_as_float((unsigned)h << 16); }
__device__ __forceinline__ float bflo(unsigned w) { return __uint_as_float(w << 16); }
__device__ __forceinline__ float bfhi(unsigned w) { return __uint_as_float(w & 0xffff0000u); }

constexpr int PLD = 8704;
struct EpiIn {
    static constexpr bool PERM = true, AFTER_DRAIN = false;
    bf16_t* P; float* LOGF; const float* lbl;
    __device__ __forceinline__ void operator()(const f32x4 (&acc)[2][2][4][2], const Unit& u, int wr, int wc, int fr, int fq) const {
        const int pn = u.pn, row0 = u.pm * BM + wr * 64 + fr, colt = pn * BM + wc * 32 + 8 * fq;
        if (pn >= 4 && pn < 8) {
            float lbv[2][8];
#pragma unroll
            for (int bj = 0; bj < 2; ++bj)
#pragma unroll
                for (int e = 0; e < 8; ++e) { const int c = colt - 1024 + bj * HALF + e; lbv[bj][e] = 1.0f / (1.0f + __expf(lbl[1024 + c] - lbl[c])); }
#pragma unroll
            for (int ai = 0; ai < 2; ++ai)
#pragma unroll
                for (int m = 0; m < 4; ++m) { float* rowp = LOGF + (size_t)(row0 + ai * HALF + m * 16) * 1024 + (colt - 1024);
#pragma unroll
                    for (int bj = 0; bj < 2; ++bj)
#pragma unroll
                        for (int n = 0; n < 2; ++n) { f32x4 z = acc[ai][bj][m][n], o;
#pragma unroll
                            for (int e = 0; e < 4; ++e) { const float lb = lbv[bj][4 * n + e]; const float sg = 1.0f / (1.0f + __expf(-z[e])); o[e] = __logf(lb + (1.0f - lb) * sg); }
                            *(f32x4*)(rowp + bj * HALF + 4 * n) = o; } }
        } else {
            const int type = (pn < 4) ? 1 : (pn < 12) ? 0 : (pn < 16) ? 1 : (pn < 22) ? 0 : 2;
            const int pcol = (pn < 4) ? colt : colt - 1024;
#pragma unroll
            for (int ai = 0; ai < 2; ++ai)
#pragma unroll
                for (int m = 0; m < 4; ++m) { bf16_t* rowp = P + (size_t)(row0 + ai * HALF + m * 16) * PLD + pcol;
#pragma unroll
                    for (int bj = 0; bj < 2; ++bj) { float v[8];
#pragma unroll
                        for (int e = 0; e < 8; ++e) v[e] = acc[ai][bj][m][e >> 2][e & 3];
                        if (type != 0) {
#pragma unroll
                            for (int e = 0; e < 8; ++e) { const float sg = __builtin_amdgcn_rcpf(1.0f + __expf(-v[e])); v[e] = (type == 1) ? v[e] * sg : sg; } }
                        u32x4 w; w.x = cvt_pk_bf16(v[0], v[1]); w.y = cvt_pk_bf16(v[2], v[3]); w.z = cvt_pk_bf16(v[4], v[5]); w.w = cvt_pk_bf16(v[6], v[7]);
                        *(u32x4*)(rowp + bj * HALF) = w; } }
        }
    }
};
struct EpiMerge {
    static constexpr bool PERM = true, AFTER_DRAIN = false;
    const bf16_t* P; bf16_t* MG;
    __device__ __forceinline__ void operator()(const f32x4 (&acc)[2][2][4][2], const Unit& u, int wr, int wc, int fr, int fq) const {
        const int br = u.pm >= 64 ? 1 : 0, pm = u.pm & 63, pn = u.pn & 7;
        const int row0 = pm * BM + wr * 64 + fr, col0 = pn * BM + wc * 32 + 8 * fq, gcol = (br ? 4608 : 6656) + col0;
#pragma unroll
        for (int ai = 0; ai < 2; ++ai)
#pragma unroll
            for (int m = 0; m < 4; ++m) { const size_t row = (size_t)(row0 + ai * HALF + m * 16);
#pragma unroll
                for (int bj = 0; bj < 2; ++bj) {
                    const u32x4 g = *(const u32x4*)(P + row * PLD + gcol + bj * HALF);
                    bf16_t* mp = MG + row * 2048 + col0 + bj * HALF;
                    float v[8];
                    v[0] = acc[ai][bj][m][0][0] * bflo(g.x); v[1] = acc[ai][bj][m][0][1] * bfhi(g.x); v[2] = acc[ai][bj][m][0][2] * bflo(g.y); v[3] = acc[ai][bj][m][0][3] * bfhi(g.y);
                    v[4] = acc[ai][bj][m][1][0] * bflo(g.z); v[5] = acc[ai][bj][m][1][1] * bfhi(g.z); v[6] = acc[ai][bj][m][1][2] * bflo(g.w); v[7] = acc[ai][bj][m][1][3] * bfhi(g.w);
                    if (br) { const u32x4 p = *(const u32x4*)mp;
                        v[0] += bflo(p.x); v[1] += bfhi(p.x); v[2] += bflo(p.y); v[3] += bfhi(p.y); v[4] += bflo(p.z); v[5] += bfhi(p.z); v[6] += bflo(p.w); v[7] += bfhi(p.w); }
                    u32x4 w; w.x = cvt_pk_bf16(v[0], v[1]); w.y = cvt_pk_bf16(v[2], v[3]); w.z = cvt_pk_bf16(v[4], v[5]); w.w = cvt_pk_bf16(v[6], v[7]);
                    *(u32x4*)mp = w; } }
    }
};
template <int WG> struct StaticOrderW {
    int nM, nN, nwg, G, c;
    __device__ void init(int M, int N, int G_, int c_) { nM = M / BM; nN = N / BM; nwg = nM * nN; G = G_; c = c_; }
    __device__ bool next(int i, Unit& u) const {
        const long L = (long)i * G + c; if (L >= nwg) return false;
        int wgid = (int)L; { const int q = nwg / NXCD, r = nwg % NXCD, xcd = wgid % NXCD, off = wgid / NXCD; wgid = (xcd < r ? xcd * (q + 1) : r * (q + 1) + (xcd - r) * q) + off; }
        const int nig = WG * nN, gid = wgid / nig, fm = gid * WG, gsz = (nM - fm) < WG ? (nM - fm) : WG;
        u.pm = fm + ((wgid % nig) % gsz); u.pn = (wgid % nig) / gsz; return true;
    }
    __device__ __forceinline__ void a_ready(const Unit&) const {}
    __device__ __forceinline__ void done(const Unit&) const {}
};
struct PairOrder {
    StaticOrderW<4> base;
    __device__ __forceinline__ bool next(int i, Unit& u) const { if (!base.next(i >> 1, u)) return false; if (i & 1) { u.pm += 64; u.pn += 8; } return true; }
    __device__ __forceinline__ void a_ready(const Unit&) const {}
    __device__ __forceinline__ void done(const Unit&) const {}
};
struct EpiRes {
    static constexpr bool PERM = false, AFTER_DRAIN = false;
    const float* base; float* out; const float* gate;
    __device__ __forceinline__ void operator()(const f32x4 (&acc)[2][2][4][2], const Unit& u, int wr, int wc, int fr, int fq) const {
        const int row0 = u.pm * BM + wr * 64 + fr, col0 = u.pn * BM + wc * 32 + 4 * fq, b = (u.pm * BM) >> 12;
        f32x4 gv[2][2];
#pragma unroll
        for (int bj = 0; bj < 2; ++bj)
#pragma unroll
            for (int n = 0; n < 2; ++n) gv[bj][n] = *(const f32x4*)(gate + (size_t)b * 12288 + col0 + bj * HALF + n * 16);
#pragma unroll
        for (int ai = 0; ai < 2; ++ai)
#pragma unroll
            for (int m = 0; m < 4; ++m) { const size_t off = (size_t)(row0 + ai * HALF + m * 16) * 2048 + col0;
#pragma unroll
                for (int bj = 0; bj < 2; ++bj)
#pragma unroll
                    for (int n = 0; n < 2; ++n) { const f32x4 bs = __builtin_nontemporal_load((const f32x4*)(base + off + bj * HALF + n * 16));
                        *(f32x4*)(out + off + bj * HALF + n * 16) = bs + gv[bj][n] * acc[ai][bj][m][n]; } }
    }
};
struct EpiRelu2 {
    static constexpr bool PERM = true, AFTER_DRAIN = false;
    bf16_t* O; int ldc;
    __device__ __forceinline__ void operator()(const f32x4 (&acc)[2][2][4][2], const Unit& u, int wr, int wc, int fr, int fq) const {
        const int row0 = u.pm * BM + wr * 64 + fr, col0 = u.pn * BM + wc * 32 + 8 * fq;
#pragma unroll
        for (int ai = 0; ai < 2; ++ai)
#pragma unroll
            for (int m = 0; m < 4; ++m) { bf16_t* rowp = O + (size_t)(row0 + ai * HALF + m * 16) * ldc + col0;
#pragma unroll
                for (int bj = 0; bj < 2; ++bj) { float v[8];
#pragma unroll
                    for (int e = 0; e < 8; ++e) { const float x = fmaxf(acc[ai][bj][m][e >> 2][e & 3], 0.f); v[e] = x * x; }
                    u32x4 w; w.x = cvt_pk_bf16(v[0], v[1]); w.y = cvt_pk_bf16(v[2], v[3]); w.z = cvt_pk_bf16(v[4], v[5]); w.w = cvt_pk_bf16(v[6], v[7]);
                    *(u32x4*)(rowp + bj * HALF) = w; } }
    }
};

struct EpiRes2 {
    static constexpr bool PERM = false, AFTER_DRAIN = false;
    const float* base; float* out; const float* mod; const float* g2; bf16_t* A2; float* rowss;
    __device__ __forceinline__ void operator()(const f32x4 (&acc)[2][2][4][2], const Unit& u, int wr, int wc, int fr, int fq) const {
        const int row0 = u.pm * BM + wr * 64 + fr, col0 = u.pn * BM + wc * 32 + 4 * fq, b = (u.pm * BM) >> 12;
        f32x4 gv[2][2], Gv[2][2];
#pragma unroll
        for (int bj = 0; bj < 2; ++bj)
#pragma unroll
            for (int n = 0; n < 2; ++n) { const int c = col0 + bj * HALF + n * 16; gv[bj][n] = *(const f32x4*)(mod + (size_t)b * 12288 + 2 * 2048 + c);
                Gv[bj][n] = *(const f32x4*)(g2 + c) * (*(const f32x4*)(mod + (size_t)b * 12288 + 4 * 2048 + c) + 1.0f); }
#pragma unroll
        for (int ai = 0; ai < 2; ++ai)
#pragma unroll
            for (int m = 0; m < 4; ++m) { const int row = row0 + ai * HALF + m * 16; const size_t off = (size_t)row * 2048 + col0; float ss = 0.f;
#pragma unroll
                for (int bj = 0; bj < 2; ++bj)
#pragma unroll
                    for (int n = 0; n < 2; ++n) { const f32x4 bs = *(const f32x4*)(base + off + bj * HALF + n * 16); const f32x4 x1 = bs + gv[bj][n] * acc[ai][bj][m][n];
                        *(f32x4*)(out + off + bj * HALF + n * 16) = x1; ss += (x1.x * x1.x + x1.y * x1.y) + (x1.z * x1.z + x1.w * x1.w);
                        const f32x4 hh = x1 * Gv[bj][n]; u32x2 w; w.x = cvt_pk_bf16(hh.x, hh.y); w.y = cvt_pk_bf16(hh.z, hh.w); *(u32x2*)(A2 + off + bj * HALF + n * 16) = w; }
                ss += __shfl_xor(ss, 16); ss += __shfl_xor(ss, 32);
                if (fq == 0) __hip_atomic_fetch_add(rowss + row, ss, __ATOMIC_RELAXED, __HIP_MEMORY_SCOPE_AGENT); }
    }
};
struct EpiUp {
    static constexpr bool PERM = true, AFTER_DRAIN = false;
    bf16_t* O; int ldc; const float* rowss; const float* cb;
    __device__ __forceinline__ void operator()(const f32x4 (&acc)[2][2][4][2], const Unit& u, int wr, int wc, int fr, int fq) const {
        const int row0 = u.pm * BM + wr * 64 + fr, col0 = u.pn * BM + wc * 32 + 8 * fq, b = (u.pm * BM) >> 12;
        f32x4 cbv[2][2];
#pragma unroll
        for (int bj = 0; bj < 2; ++bj)
#pragma unroll
            for (int n = 0; n < 2; ++n) cbv[bj][n] = *(const f32x4*)(cb + (size_t)b * 8192 + col0 + bj * HALF + 4 * n);
#pragma unroll
        for (int ai = 0; ai < 2; ++ai)
#pragma unroll
            for (int m = 0; m < 4; ++m) { const int row = row0 + ai * HALF + m * 16; bf16_t* rowp = O + (size_t)row * ldc + col0;
                const float rstd = 1.0f / sqrtf(__hip_atomic_load(rowss + row, __ATOMIC_RELAXED, __HIP_MEMORY_SCOPE_AGENT) * (1.0f / 2048.0f) + 1e-6f);
#pragma unroll
                for (int bj = 0; bj < 2; ++bj) { float v[8];
#pragma unroll
                    for (int e = 0; e < 8; ++e) { const float x = fmaxf(acc[ai][bj][m][e >> 2][e & 3] * rstd + cbv[bj][e >> 2][e & 3], 0.f); v[e] = x * x; }
                    u32x4 w; w.x = cvt_pk_bf16(v[0], v[1]); w.y = cvt_pk_bf16(v[2], v[3]); w.z = cvt_pk_bf16(v[4], v[5]); w.w = cvt_pk_bf16(v[6], v[7]);
                    *(u32x4*)(rowp + bj * HALF) = w; } }
    }
};

struct EpiRes3 {
    static constexpr bool PERM = false, AFTER_DRAIN = false;
    const float* base; float* out; const float* mod; const float* g2; bf16_t* A2; float* part;
    __device__ __forceinline__ void operator()(const f32x4 (&acc)[2][2][4][2], const Unit& u, int wr, int wc, int fr, int fq) const {
        const int row0 = u.pm * BM + wr * 64 + fr, col0 = u.pn * BM + wc * 32 + 4 * fq, b = (u.pm * BM) >> 12;
        f32x4 gv[2][2], Gv[2][2];
#pragma unroll
        for (int bj = 0; bj < 2; ++bj)
#pragma unroll
            for (int n = 0; n < 2; ++n) { const int c = col0 + bj * HALF + n * 16; gv[bj][n] = *(const f32x4*)(mod + (size_t)b * 12288 + 2 * 2048 + c);
                Gv[bj][n] = *(const f32x4*)(g2 + c) * (*(const f32x4*)(mod + (size_t)b * 12288 + 4 * 2048 + c) + 1.0f); }
        float* prow = part + (size_t)(u.pn * 4 + wc) * 16384;
#pragma unroll
        for (int ai = 0; ai < 2; ++ai)
#pragma unroll
            for (int m = 0; m < 4; ++m) { const int row = row0 + ai * HALF + m * 16; const size_t off = (size_t)row * 2048 + col0; float ss = 0.f;
#pragma unroll
                for (int bj = 0; bj < 2; ++bj)
#pragma unroll
                    for (int n = 0; n < 2; ++n) { const f32x4 bs = __builtin_nontemporal_load((const f32x4*)(base + off + bj * HALF + n * 16)); const f32x4 x1 = bs + gv[bj][n] * acc[ai][bj][m][n];
                        *(f32x4*)(out + off + bj * HALF + n * 16) = x1; ss += (x1.x * x1.x + x1.y * x1.y) + (x1.z * x1.z + x1.w * x1.w);
                        const f32x4 hh = x1 * Gv[bj][n]; u32x2 w; w.x = cvt_pk_bf16(hh.x, hh.y); w.y = cvt_pk_bf16(hh.z, hh.w); *(u32x2*)(A2 + off + bj * HALF + n * 16) = w; }
                ss += __shfl_xor(ss, 16); ss += __shfl_xor(ss, 32);
                if (fq == 0) prow[row] = ss; }
    }
};
struct EpiUp2 {
    static constexpr bool PERM = true, AFTER_DRAIN = false;
    bf16_t* O; int ldc; const PG8_LAS float* rstd; const float* cb;
    __device__ __forceinline__ void operator()(const f32x4 (&acc)[2][2][4][2], const Unit& u, int wr, int wc, int fr, int fq) const {
        const int row0 = u.pm * BM + wr * 64 + fr, col0 = u.pn * BM + wc * 32 + 8 * fq, b = (u.pm * BM) >> 12;
        f32x4 cbv[2][2];
#pragma unroll
        for (int bj = 0; bj < 2; ++bj)
#pragma unroll
            for (int n = 0; n < 2; ++n) cbv[bj][n] = *(const f32x4*)(cb + (size_t)b * 8192 + col0 + bj * HALF + 4 * n);
#pragma unroll
        for (int ai = 0; ai < 2; ++ai)
#pragma unroll
            for (int m = 0; m < 4; ++m) { const int rl = wr * 64 + fr + ai * HALF + m * 16; bf16_t* rowp = O + (size_t)(u.pm * BM + rl) * ldc + col0;
                const float rs = rstd[((u.pm >> 2) & 1) * 256 + rl];
#pragma unroll
                for (int bj = 0; bj < 2; ++bj) { float v[8];
#pragma unroll
                    for (int e = 0; e < 8; ++e) { const float x = fmaxf(acc[ai][bj][m][e >> 2][e & 3] * rs + cbv[bj][e >> 2][e & 3], 0.f); v[e] = x * x; }
                    u32x4 w; w.x = cvt_pk_bf16(v[0], v[1]); w.y = cvt_pk_bf16(v[2], v[3]); w.z = cvt_pk_bf16(v[4], v[5]); w.w = cvt_pk_bf16(v[6], v[7]);
                    *(u32x4*)(rowp + bj * HALF) = w; } }
    }
};

struct InOrder {
    StaticOrderW<4> base;
    __device__ __forceinline__ bool next(int i, Unit& u) const { if (!base.next(i, u)) return false; const int p = u.pn;
        u.pn = p < 16 ? 22 + p : p < 20 ? p - 16 : p < 24 ? p - 20 + 12 : p < 28 ? p - 24 + 4 : p < 32 ? p - 28 + 8 : p - 32 + 16; return true; }
    __device__ __forceinline__ void a_ready(const Unit&) const {}
    __device__ __forceinline__ void done(const Unit&) const {}
};
template <class Epi, class Sched, bool ALIGN_EPI = false, bool SP2 = false>
__device__ __forceinline__ void gemm_phase(PG8_LAS unsigned char* lds, const Gemm g, const Sched& S, const Epi& E) {
    int tid_ = threadIdx.x; asm volatile("" : "+v"(tid_));
    const int tid = tid_, wid = __builtin_amdgcn_readfirstlane(tid >> 6), lane = tid & 63, wr = wid >> 2, wc = wid & 3, fr = lane & 15, fq = lane >> 4;
    const int K = g.K, nt = K / BK;
    unsigned voffA[2], voffB[2];
#pragma unroll
    for (int i = 0; i < 2; ++i) { int R, C; stage_rc(tid * 16 + i * 8192, R, C); const int Rb = Epi::PERM ? ((R & ~31) + perm32(R & 31)) : R;
        voffA[i] = (unsigned)(R * K + C) * 2u; voffB[i] = (unsigned)(Rb * K + C) * 2u; }
    const size_t kstep = (size_t)(BK * 2);
    const size_t hstep = (size_t)HALF * K * 2;
    const size_t tstep = 2 * hstep;
    const unsigned ldsw = (unsigned)wid * 1024u;
    const int aoff = lds_byte(wr * 64 + fr, fq * 8), boff = lds_byte(wc * 32 + fr, fq * 8);
#define PG8_SA(b, h) (((b) * 2 + (h)) * HTB)
#define PG8_SB(b, h) ((4 + (b) * 2 + (h)) * HTB)
#define PG8_STAGE(bufoff, gbase, voff) do { _Pragma("unroll") for (int _i = 0; _i < 2; ++_i) \
        __builtin_amdgcn_global_load_lds((const unsigned*)((const char*)(gbase) + (voff)[_i]), (PG8_LAS unsigned*)(lds + (bufoff) + ldsw + _i * 8192), 16, 0, 0); } while (0)
#define PG8_LDA(dst, b, h) do { _Pragma("unroll") for (int m = 0; m < 4; ++m) _Pragma("unroll") for (int k = 0; k < 2; ++k) dst[m][k] = *(const PG8_LAS bf16x8*)(lds + PG8_SA(b, h) + aoff + m * 2048 + k * 1024); } while (0)
#define PG8_LDB(dst, b, h) do { _Pragma("unroll") for (int n = 0; n < 2; ++n) _Pragma("unroll") for (int k = 0; k < 2; ++k) dst[n][k] = *(const PG8_LAS bf16x8*)(lds + PG8_SB(b, h) + boff + n * 2048 + k * 1024); } while (0)
#define PG8_MMA(ai, bj, At, Bt) do { __builtin_amdgcn_s_setprio(1); _Pragma("unroll") for (int m = 0; m < 4; ++m) _Pragma("unroll") for (int n = 0; n < 2; ++n) _Pragma("unroll") for (int k = 0; k < 2; ++k) \
        acc[ai][bj][m][n] = __builtin_amdgcn_mfma_f32_16x16x32_bf16(Bt[n][k], At[m][k], acc[ai][bj][m][n], 0, 0, 0); __builtin_amdgcn_s_setprio(0); } while (0)
#define PG8_WAIT_V(n) asm volatile("s_waitcnt vmcnt(" #n ")" ::: "memory")
#define PG8_WAIT_L(n) asm volatile("s_waitcnt lgkmcnt(" #n ")" ::: "memory")
#define PG8_BAR __builtin_amdgcn_s_barrier()
#define PG8_SCHED __builtin_amdgcn_sched_barrier(0)
    Unit cur, nxt; int ui = 0;
    if (!S.next(0, cur)) return;
    f32x4 acc[2][2][4][2];
#pragma unroll
    for (int a = 0; a < 2; ++a)
#pragma unroll
        for (int b = 0; b < 2; ++b)
#pragma unroll
            for (int m = 0; m < 4; ++m)
#pragma unroll
                for (int n = 0; n < 2; ++n) acc[a][b][m][n] = (f32x4){0.f, 0.f, 0.f, 0.f};
    bf16x8 At[4][2], B0[2][2], B1[2][2];
    const char* cA = (const char*)g.A + (size_t)cur.pm * tstep; const char* cB = (const char*)g.Bt + (size_t)cur.pn * tstep;
    S.a_ready(cur);
    if constexpr (SP2) {
        PG8_STAGE(PG8_SB(0, 0), cB, voffB); PG8_STAGE(PG8_SB(0, 1), cB + hstep, voffB); PG8_STAGE(PG8_SA(0, 0), cA, voffA); PG8_STAGE(PG8_SA(0, 1), cA + hstep, voffA);
        if (wr == 1) PG8_BAR;
        PG8_WAIT_V(2); PG8_BAR;
        PG8_STAGE(PG8_SB(1, 0), cB + kstep, voffB); PG8_STAGE(PG8_SA(1, 0), cA + kstep, voffA); PG8_STAGE(PG8_SB(1, 1), cB + hstep + kstep, voffB);
        PG8_WAIT_V(6); PG8_BAR;
    } else {
        PG8_STAGE(PG8_SB(0, 0), cB, voffB); PG8_STAGE(PG8_SA(0, 0), cA, voffA); PG8_STAGE(PG8_SB(0, 1), cB + hstep, voffB); PG8_STAGE(PG8_SA(0, 1), cA + hstep, voffA);
        if (wr == 1) PG8_BAR;
        PG8_WAIT_V(4); PG8_BAR;
        PG8_STAGE(PG8_SB(1, 0), cB + kstep, voffB); PG8_STAGE(PG8_SA(1, 0), cA + kstep, voffA); PG8_STAGE(PG8_SB(1, 1), cB + hstep + kstep, voffB);
        PG8_WAIT_V(6); PG8_BAR;
    }
    for (;;) {
        const bool has_next = S.next(ui + 1, nxt);
        const char* nA = has_next ? (const char*)g.A + (size_t)nxt.pm * tstep : cA; const char* nB = has_next ? (const char*)g.Bt + (size_t)nxt.pn * tstep : cB;
        for (int t = 0; t < nt; t += 2) {
            const bool last = (t == nt - 2);
            const char* a1 = cA + (size_t)(t + 1) * kstep;
            const char* a2 = last ? nA : cA + (size_t)(t + 2) * kstep; const char* b2 = last ? nB : cB + (size_t)(t + 2) * kstep;
            const char* a3 = a2 + kstep; const char* b3 = b2 + kstep;
            if (last && has_next) S.a_ready(nxt);
            if constexpr (SP2) {
            PG8_LDB(B0, 0, 0); PG8_LDB(B1, 0, 1); PG8_SCHED; PG8_LDA(At, 0, 0); PG8_STAGE(PG8_SA(1, 1), a1 + hstep, voffA);
            PG8_WAIT_V(8); PG8_WAIT_L(0); PG8_BAR; PG8_MMA(0, 0, At, B0); PG8_MMA(0, 1, At, B1); PG8_BAR; PG8_SCHED;
            PG8_LDA(At, 0, 1); PG8_STAGE(PG8_SB(0, 0), b2, voffB); PG8_STAGE(PG8_SB(0, 1), b2 + hstep, voffB); PG8_STAGE(PG8_SA(0, 0), a2, voffA);
            PG8_WAIT_V(8); PG8_WAIT_L(0); PG8_BAR; PG8_MMA(1, 0, At, B0); PG8_MMA(1, 1, At, B1); PG8_BAR; PG8_SCHED;
            PG8_LDB(B0, 1, 0); PG8_LDB(B1, 1, 1); PG8_SCHED; PG8_LDA(At, 1, 0); PG8_STAGE(PG8_SA(0, 1), a2 + hstep, voffA);
            PG8_WAIT_V(8); PG8_WAIT_L(0); PG8_BAR; PG8_MMA(0, 0, At, B0); PG8_MMA(0, 1, At, B1); PG8_BAR; PG8_SCHED;
            PG8_LDA(At, 1, 1); PG8_STAGE(PG8_SB(1, 0), b3, voffB); PG8_STAGE(PG8_SB(1, 1), b3 + hstep, voffB); PG8_STAGE(PG8_SA(1, 0), a3, voffA);
            PG8_WAIT_V(8); PG8_WAIT_L(0); PG8_BAR; PG8_MMA(1, 0, At, B0); PG8_MMA(1, 1, At, B1); PG8_BAR; PG8_SCHED;
            } else {
            PG8_LDB(B0, 0, 0); PG8_SCHED; PG8_LDA(At, 0, 0); PG8_STAGE(PG8_SA(1, 1), a1 + hstep, voffA);
            PG8_WAIT_L(8); PG8_BAR; PG8_WAIT_L(0); PG8_MMA(0, 0, At, B0); PG8_BAR; PG8_SCHED;
            PG8_LDB(B1, 0, 1); PG8_STAGE(PG8_SB(0, 0), b2, voffB);
            PG8_BAR; PG8_WAIT_L(0); PG8_MMA(0, 1, At, B1); PG8_BAR;
            PG8_LDA(At, 0, 1); PG8_STAGE(PG8_SA(0, 0), a2, voffA);
            PG8_BAR; PG8_WAIT_L(0); PG8_MMA(1, 0, At, B0); PG8_BAR; PG8_SCHED;
            PG8_STAGE(PG8_SB(0, 1), b2 + hstep, voffB);
            PG8_WAIT_V(6); PG8_BAR; PG8_MMA(1, 1, At, B1); PG8_BAR;
            PG8_LDB(B0, 1, 0); PG8_SCHED; PG8_LDA(At, 1, 0); PG8_STAGE(PG8_SA(0, 1), a2 + hstep, voffA);
            PG8_WAIT_L(8); PG8_BAR; PG8_WAIT_L(0); PG8_MMA(0, 0, At, B0); PG8_BAR; PG8_SCHED;
            PG8_LDB(B1, 1, 1); PG8_STAGE(PG8_SB(1, 0), b3, voffB);
            PG8_BAR; PG8_WAIT_L(0); PG8_MMA(0, 1, At, B1); PG8_BAR;
            PG8_LDA(At, 1, 1); PG8_STAGE(PG8_SA(1, 0), a3, voffA);
            PG8_BAR; PG8_WAIT_L(0); PG8_MMA(1, 0, At, B0); PG8_BAR; PG8_SCHED;
            PG8_STAGE(PG8_SB(1, 1), b3 + hstep, voffB);
            PG8_WAIT_V(6); PG8_BAR; PG8_MMA(1, 1, At, B1); PG8_BAR;
            }
        }
        if constexpr (ALIGN_EPI) { if (wr == 0) PG8_BAR; }
        if constexpr (!Epi::AFTER_DRAIN) { E(acc, cur, wr, wc, fr, fq); S.done(cur); }
        if (!has_next) break;
#pragma unroll
        for (int a = 0; a < 2; ++a)
#pragma unroll
            for (int b = 0; b < 2; ++b)
#pragma unroll
                for (int m = 0; m < 4; ++m)
#pragma unroll
                    for (int n = 0; n < 2; ++n) acc[a][b][m][n] = (f32x4){0.f, 0.f, 0.f, 0.f};
        cur = nxt; cA = nA; cB = nB; ++ui;
        if constexpr (ALIGN_EPI) { if (wr == 1) PG8_BAR; }
    }
    PG8_WAIT_V(0);
    if constexpr (!ALIGN_EPI) { if (wr == 0) PG8_BAR; }
    PG8_BAR;
    if constexpr (Epi::AFTER_DRAIN) { E.fused(acc, cur, wr, wc, fr, fq, lds, wid, lane); S.done(cur); }
#undef PG8_SA
#undef PG8_SB
#undef PG8_STAGE
#undef PG8_LDA
#undef PG8_LDB
#undef PG8_MMA
#undef PG8_WAIT_V
#undef PG8_WAIT_L
#undef PG8_BAR
#undef PG8_SCHED
}
}
#define LAS __attribute__((address_space(3)))
typedef unsigned short bf16_t;
typedef short bf16x8 __attribute__((ext_vector_type(8)));
typedef float f32x4 __attribute__((ext_vector_type(4)));
typedef unsigned u32x4 __attribute__((ext_vector_type(4)));
typedef unsigned u32x2 __attribute__((ext_vector_type(2)));
using pg8::cvt_pk_bf16; using pg8::bflo; using pg8::bfhi; using pg8::bf2f; using pg8::PLD;
constexpr int DM = 2048, SEQ = 4096, NB = 4, M = NB * SEQ, INW = 9728, HID = 8192, NMOD = 6 * DM;
constexpr float EPS = 1e-6f;
constexpr size_t MiB = 1u << 20;
constexpr size_t WS_MOD = 0, WS_WIN = 1 * MiB, WS_WAB = 39 * MiB, WS_WO = 47 * MiB, WS_W1 = 55 * MiB, WS_W2 = 87 * MiB, WS_H = 120 * MiB, WS_P = 184 * MiB, WS_SSEG = 456 * MiB, WS_DSEG = 472 * MiB, WS_H2 = 440 * MiB, WS_PART = 504 * MiB, WS_END = 506 * MiB;
constexpr size_t WS_CB = 256 * 1024;
constexpr size_t WS_BAR = 512 * 1024, BAR_BYTES = 16384, WS_ROWSS = WS_BAR + BAR_BYTES, ZERO_BYTES = BAR_BYTES;
constexpr int MISC_OFF = 147456 - 64;
constexpr int LDS_BYTES = 147456;
constexpr int NTHR = 512;

__device__ __forceinline__ float wave_sum(float v) {
#pragma unroll
    for (int o = 1; o < 64; o <<= 1) v += __shfl_xor(v, o);
    return v;
}
__device__ __forceinline__ bf16x8 ldfrag(const LAS bf16_t* base, int pitch, int row, int kofs) { return *(const LAS bf16x8*)(base + row * pitch + kofs); }
#define MFMA16(a, b, c) __builtin_amdgcn_mfma_f32_16x16x32_bf16((a), (b), (c), 0, 0, 0)
#define LBAR() do { asm volatile("s_waitcnt lgkmcnt(0)" ::: "memory"); __builtin_amdgcn_s_barrier(); asm volatile("" ::: "memory"); } while (0)
#define XB_TMO      128
#define XB_XCNT(j)  (256  + 64 * (j))
#define XB_XSUB(j)  (1280 + 64 * (j))
#define XB_XGEN(j)  (2304 + 64 * (j))
#define XB_TOP      3328
#define XB_TOPGEN   3392
#define XCD_BAR_WORDS 3456
#define XB_SPIN_CAP (1u << 18)

__device__ __forceinline__ unsigned xb_ld(unsigned* p)              { return __hip_atomic_load(p, __ATOMIC_RELAXED, __HIP_MEMORY_SCOPE_AGENT); }
__device__ __forceinline__ unsigned xb_add(unsigned* p, unsigned v) { return __hip_atomic_fetch_add(p, v, __ATOMIC_RELAXED, __HIP_MEMORY_SCOPE_AGENT); }
__device__ __forceinline__ unsigned xb_xcc_id() { return (unsigned)__builtin_amdgcn_s_getreg((3 << 11) | 20) & 0xFu; }
#define XB_SPIN(cond, bar) do { unsigned _sp = 0; while (cond) { __builtin_amdgcn_s_sleep(1); \
    if ((++_sp & 255u) == 0u) { if (xb_ld(&(bar)[XB_TMO])) break; if (_sp > XB_SPIN_CAP) { atomicAdd(&(bar)[XB_TMO], 1u); break; } } } } while (0)

struct XcdBarrier {
    unsigned* bar; unsigned x;
    volatile LAS unsigned* st;
};

__device__ __forceinline__ XcdBarrier xcd_barrier_post(unsigned* bar, volatile LAS unsigned* st) {
    XcdBarrier b; b.bar = bar; b.x = xb_xcc_id(); b.st = st;
    if (threadIdx.x == 0) (void)xb_add(&bar[XB_XCNT(b.x)], 1u);
    return b;
}
__device__ __forceinline__ void xcd_barrier_complete(unsigned* bar, unsigned x, unsigned& nloc, unsigned& nx) {
    const unsigned G = gridDim.x * gridDim.y * gridDim.z;
    unsigned sum, cnt, mine, sp = 0u;
    for (;;) {
        sum = 0u; cnt = 0u; mine = 0u;
#pragma unroll
        for (unsigned j = 0; j < 16; ++j) { const unsigned c = xb_ld(&bar[XB_XCNT(j)]); sum += c; cnt += (c > 0u) ? 1u : 0u; mine = (j == x) ? c : mine; }
        if (sum == G) break;
        __builtin_amdgcn_s_sleep(1);
        if ((++sp & 255u) == 0u) { if (xb_ld(&bar[XB_TMO])) break; if (sp > XB_SPIN_CAP) { atomicAdd(&bar[XB_TMO], 1u); break; } }
    }
    nloc = mine > 0u ? mine : 1u; nx = cnt > 0u ? cnt : 1u;
}

__device__ __forceinline__ void xcd_barrier(const XcdBarrier& b) {
    asm volatile("s_waitcnt vmcnt(0)" ::: "memory");
    __syncthreads();
    if (threadIdx.x == 0) {
        unsigned* bar = b.bar;
        __builtin_amdgcn_s_waitcnt(0);
        unsigned nloc = b.st[0], nx = b.st[1];
        if (nloc == 0u) { xcd_barrier_complete(bar, b.x, nloc, nx); b.st[0] = nloc; b.st[1] = nx; }
        const unsigned old = xb_add(&bar[XB_XSUB(b.x)], 1u);
        const unsigned gen = old / nloc;
        if (old + 1u == (gen + 1u) * nloc) {
            __builtin_amdgcn_fence(__ATOMIC_RELEASE, "agent");
            asm volatile("s_waitcnt vmcnt(0)" ::: "memory");
            const unsigned og = xb_add(&bar[XB_TOP], 1u);
            const unsigned tg = og / nx;
            if (og + 1u == (tg + 1u) * nx) xb_add(&bar[XB_TOPGEN], 1u);
            else XB_SPIN(xb_ld(&bar[XB_TOPGEN]) == tg, bar);
            __builtin_amdgcn_fence(__ATOMIC_ACQUIRE, "agent");
            xb_add(&bar[XB_XGEN(b.x)], 1u);
            asm volatile("s_waitcnt vmcnt(0)" ::: "memory");
        } else {
            XB_SPIN(xb_ld(&bar[XB_XGEN(b.x)]) == gen, bar);
            __builtin_amdgcn_fence(__ATOMIC_ACQUIRE, "agent");
            asm volatile("s_waitcnt vmcnt(0)" ::: "memory");
        }
    }
    __syncthreads();
}


struct TrDesc { const float* W; bf16_t* WT; int K, N, row_off, item; };
__device__ __forceinline__ void tr_load(const TrDesc& d, int lane, f32x4 (&v)[16]) {
    const int nkb = d.K / 64, kb = d.item % nkb, nb = d.item / nkb, k0 = 64 * kb, n0 = 64 * nb;
    const float* p = d.W + (size_t)(k0 + (lane >> 4)) * d.N + n0 + 4 * (lane & 15);
#pragma unroll
    for (int i = 0; i < 16; ++i) v[i] = __builtin_nontemporal_load((const f32x4*)(p + (size_t)(4 * i) * d.N));
}
__device__ __forceinline__ void tr_store(const TrDesc& d, int lane, const f32x4 (&v)[16], LAS float* scr) {
    const int nkb = d.K / 64, kb = d.item % nkb, nb = d.item / nkb, k0 = 64 * kb, n0 = 64 * nb;
#pragma unroll
    for (int i = 0; i < 16; ++i) { LAS float* s = scr + (4 * i + (lane >> 4)) * 65 + 4 * (lane & 15); s[0] = v[i].x; s[1] = v[i].y; s[2] = v[i].z; s[3] = v[i].w; }
    __builtin_amdgcn_wave_barrier();
    const int c = lane & 7;
#pragma unroll
    for (int j = 0; j < 8; ++j) { const int n = (lane >> 3) + 8 * j; const LAS float* s = scr + (8 * c) * 65 + n;
        u32x4 o; o.x = cvt_pk_bf16(s[0 * 65], s[1 * 65]); o.y = cvt_pk_bf16(s[2 * 65], s[3 * 65]); o.z = cvt_pk_bf16(s[4 * 65], s[5 * 65]); o.w = cvt_pk_bf16(s[6 * 65], s[7 * 65]);
        *(u32x4*)(d.WT + (size_t)(d.row_off + n0 + n) * d.K + k0 + 8 * c) = o; }
    __builtin_amdgcn_wave_barrier();
}
__device__ __forceinline__ void gemv_item(const float* __restrict__ cvec, const float* __restrict__ Wada, const float* __restrict__ bada, float* mod, LAS unsigned char* lds, int item, int tid) {
    LAS f32x4* sc = (LAS f32x4*)lds;
    LAS float* red = (LAS float*)(lds + 32768);
    for (int k = tid; k < DM; k += NTHR) { f32x4 v;
#pragma unroll
        for (int b = 0; b < 4; ++b) { const float x = cvec[b * DM + k]; v[b] = x / (1.0f + __expf(-x)); }
        sc[k] = v; }
    __syncthreads();
    const int c4 = tid % 12, rl = tid / 12, n0 = item * 48;
    f32x4 a0 = {0.f, 0.f, 0.f, 0.f}, a1 = a0, a2 = a0, a3 = a0;
    if (rl < 42) {
        const float* wp = Wada + n0 + 4 * c4;
#pragma unroll 16
        for (int k = rl; k < DM; k += 42) { const f32x4 w = __builtin_nontemporal_load((const f32x4*)(wp + (size_t)k * NMOD)); const f32x4 s = sc[k]; a0 += w * s.x; a1 += w * s.y; a2 += w * s.z; a3 += w * s.w; }
        LAS f32x4* r = (LAS f32x4*)red + (rl * 12 + c4) * 4; r[0] = a0; r[1] = a1; r[2] = a2; r[3] = a3;
    }
    __syncthreads();
    if (tid < 192) { const int b = tid / 48, col = tid % 48, cc = col >> 2, e = col & 3; float s = 0.f;
        for (int r = 0; r < 42; ++r) s += red[((r * 12 + cc) * 4 + b) * 4 + e];
        mod[(size_t)b * NMOD + n0 + col] = s + bada[n0 + col]; }
    __syncthreads();
}
__device__ __forceinline__ void norm_phase(const float* X, const float* __restrict__ gain, const float* mod, int sh_off, int sc_off, bf16_t* H, int gw, int NGW, int lane) {
    for (int rg = gw; rg < M / 8; rg += NGW) {
        const int row0 = rg * 8, b = row0 >> 12;
        f32x4 gs[8], sh[8];
#pragma unroll
        for (int j = 0; j < 8; ++j) { const f32x4 g = ((const f32x4*)gain)[lane + 64 * j]; const f32x4 s = ((const f32x4*)(mod + (size_t)b * NMOD + sc_off))[lane + 64 * j];
            gs[j] = g * (s + 1.0f); sh[j] = ((const f32x4*)(mod + (size_t)b * NMOD + sh_off))[lane + 64 * j]; }
        for (int r = 0; r < 8; ++r) {
            const f32x4* xr = (const f32x4*)(X + (size_t)(row0 + r) * DM) + lane;
            f32x4 v[8]; float ss = 0.f;
#pragma unroll
            for (int j = 0; j < 8; ++j) { v[j] = __builtin_nontemporal_load(xr + 64 * j); ss += (v[j].x * v[j].x + v[j].y * v[j].y) + (v[j].z * v[j].z + v[j].w * v[j].w); }
            const float rstd = 1.0f / sqrtf(wave_sum(ss) * (1.0f / DM) + EPS);
            u32x2* o8 = (u32x2*)(H + (size_t)(row0 + r) * DM) + lane;
#pragma unroll
            for (int j = 0; j < 8; ++j) { const f32x4 y = v[j] * rstd * gs[j] + sh[j]; u32x2 w; w.x = cvt_pk_bf16(y.x, y.y); w.y = cvt_pk_bf16(y.z, y.w); o8[64 * j] = w; }
        }
    }
}
__device__ __forceinline__ void bias_phase(const bf16_t* W1T, const float* mod, float* cb, int gw, int NGW, int lane) {
    for (int n = gw; n < HID; n += NGW) {
        float w[32];
#pragma unroll
        for (int j = 0; j < 4; ++j) { const u32x4 r = *(const u32x4*)(W1T + (size_t)n * DM + (j * 64 + lane) * 8);
            w[8 * j + 0] = bflo(r.x); w[8 * j + 1] = bfhi(r.x); w[8 * j + 2] = bflo(r.y); w[8 * j + 3] = bfhi(r.y); w[8 * j + 4] = bflo(r.z); w[8 * j + 5] = bfhi(r.z); w[8 * j + 6] = bflo(r.w); w[8 * j + 7] = bfhi(r.w); }
#pragma unroll
        for (int b = 0; b < 4; ++b) { const float* sh = mod + (size_t)b * NMOD + 3 * DM; float s = 0.f;
#pragma unroll
            for (int j = 0; j < 4; ++j) { const f32x4 s0 = *(const f32x4*)(sh + (j * 64 + lane) * 8), s1 = *(const f32x4*)(sh + (j * 64 + lane) * 8 + 4);
                s += (w[8 * j + 0] * s0.x + w[8 * j + 1] * s0.y) + (w[8 * j + 2] * s0.z + w[8 * j + 3] * s0.w) + (w[8 * j + 4] * s1.x + w[8 * j + 5] * s1.y) + (w[8 * j + 6] * s1.z + w[8 * j + 7] * s1.w); }
            s = wave_sum(s);
            if (lane == 0) cb[(size_t)b * HID + n] = s; }
    }
}
typedef float f32x2 __attribute__((ext_vector_type(2)));
typedef short v4i16_t __attribute__((ext_vector_type(4)));
template <bool FULL>
__device__ __forceinline__ void hgrn_seg(int b, int h, int sg, const bf16_t* P, const float* LOGF, const float* __restrict__ ogain, bf16_t* OA, float* SSEG, float* DSEG, LAS unsigned char* lds, int tid) {
    const int lane = tid & 63, wid = __builtin_amdgcn_readfirstlane(tid >> 6), fr = lane & 15, fq = lane >> 4;
    LAS bf16_t* Qd = (LAS bf16_t*)lds;
    LAS bf16_t* Kd = Qd + 64 * 136;
    LAS bf16_t* Qb = Kd + 64 * 136;
    LAS bf16_t* KlT = Qb + 64 * 136;
    LAS bf16_t* VT = KlT + 128 * 72;
    LAS bf16_t* Pm = VT + 128 * 72;
    LAS bf16_t* ST = Pm + 64 * 72;
    LAS float* segtot = (LAS float*)(ST + 128 * 136);
    LAS float* dec = segtot + 1024;
    LAS float* rsq = dec + 128;
    const int unit = (b * 8 + h) * 8 + sg;
    f32x4 sacc[8];
#pragma unroll
    for (int kt = 0; kt < 8; ++kt) sacc[kt] = (f32x4){0.f, 0.f, 0.f, 0.f};
    const int kp = lane, t0 = wid * 8;
    const int tt = wid & 3, vh = wid >> 2;
    f32x4 gn[4];
    if (FULL) {
        for (int j = 0; j < sg; ++j) { const int uj = unit - sg + j;
#pragma unroll
            for (int kt = 0; kt < 8; ++kt) { const f32x4 d = *(const f32x4*)(DSEG + (size_t)uj * 128 + kt * 16 + 4 * fq); const f32x4 sv = *(const f32x4*)(SSEG + ((size_t)uj * 8 + kt) * 2048 + tid * 4); sacc[kt] = sacc[kt] * d + sv; } }
#pragma unroll
        for (int kt = 0; kt < 8; ++kt) { u32x2 w; w.x = cvt_pk_bf16(sacc[kt][0], sacc[kt][1]); w.y = cvt_pk_bf16(sacc[kt][2], sacc[kt][3]);
            *(LAS u32x2*)(ST + (wid * 16 + fr) * 136 + kt * 16 + 4 * fq) = w; }
#pragma unroll
        for (int vt = 0; vt < 4; ++vt) gn[vt] = *(const f32x4*)(ogain + h * 128 + (vh * 4 + vt) * 16 + 4 * fq);
    }
    f32x2 dsum = {0.f, 0.f};
    f32x2 lf[8]; unsigned qv[8], vv[8];
    {   const size_t r0 = (size_t)b * SEQ + (size_t)(sg * 8) * 64;
#pragma unroll
        for (int j = 0; j < 8; ++j) { const size_t row = r0 + t0 + j; lf[j] = *(const f32x2*)(LOGF + row * 1024 + h * 128 + 2 * kp); vv[j] = *(const unsigned*)(P + row * PLD + 1024 + h * 128 + 2 * kp); if (FULL) qv[j] = *(const unsigned*)(P + row * PLD + h * 128 + 2 * kp); } }
    LBAR();
    for (int n = 0; n < 8; ++n) {
        const size_t r0 = (size_t)b * SEQ + (size_t)(sg * 8 + n) * 64;
        f32x2 cs[8];
        { f32x2 a = {0.f, 0.f};
#pragma unroll
          for (int j = 0; j < 8; ++j) { a += lf[j]; cs[j] = a; } }
        *(LAS f32x2*)(segtot + wid * 128 + 2 * kp) = cs[7];
        u32x2 gg[4];
        if (FULL) {
#pragma unroll
            for (int vt = 0; vt < 4; ++vt) gg[vt] = *(const u32x2*)(P + (r0 + tt * 16 + fr) * PLD + 2048 + h * 128 + (vh * 4 + vt) * 16 + 4 * fq);
        }
        LBAR();
        f32x2 off = {0.f, 0.f}, bmid = {0.f, 0.f}, blast = {0.f, 0.f};
#pragma unroll
        for (int s8 = 0; s8 < 8; ++s8) { const f32x2 tv = *(const LAS f32x2*)(segtot + s8 * 128 + 2 * kp); if (s8 < wid) off += tv; if (s8 < 4) bmid += tv; blast += tv; }
        dsum += blast;
        f32x2 emid, elm;
        emid.x = __expf(bmid.x); emid.y = __expf(bmid.y); elm.x = __expf(blast.x - bmid.x); elm.y = __expf(blast.y - bmid.y);
        float kl0[8], kl1[8];
#pragma unroll
        for (int j = 0; j < 8; ++j) { const f32x2 bb = cs[j] + off;
            const float f0 = __expf(lf[j].x), f1 = __expf(lf[j].y), kk0 = 1.0f - f0, kk1 = 1.0f - f1;
            const float e0 = __expf(bb.x - bmid.x), e1 = __expf(bb.y - bmid.y), i0 = __expf(bmid.x - bb.x), i1 = __expf(bmid.y - bb.y);
            if (FULL) { const float q0 = bflo(qv[j]), q1 = bfhi(qv[j]);
                *(LAS unsigned*)(Qd + (t0 + j) * 136 + 2 * kp) = cvt_pk_bf16(q0 * e0, q1 * e1);
                *(LAS unsigned*)(Kd + (t0 + j) * 136 + 2 * kp) = cvt_pk_bf16(kk0 * i0, kk1 * i1);
                *(LAS unsigned*)(Qb + (t0 + j) * 136 + 2 * kp) = cvt_pk_bf16(q0 * e0 * emid.x, q1 * e1 * emid.y); }
            kl0[j] = kk0 * i0 * elm.x; kl1[j] = kk1 * i1 * elm.y; }
        { u32x4 w0, w1; w0.x = cvt_pk_bf16(kl0[0], kl0[1]); w0.y = cvt_pk_bf16(kl0[2], kl0[3]); w0.z = cvt_pk_bf16(kl0[4], kl0[5]); w0.w = cvt_pk_bf16(kl0[6], kl0[7]);
          w1.x = cvt_pk_bf16(kl1[0], kl1[1]); w1.y = cvt_pk_bf16(kl1[2], kl1[3]); w1.z = cvt_pk_bf16(kl1[4], kl1[5]); w1.w = cvt_pk_bf16(kl1[6], kl1[7]);
          *(LAS u32x4*)(KlT + (2 * kp) * 72 + t0) = w0; *(LAS u32x4*)(KlT + (2 * kp + 1) * 72 + t0) = w1;
          u32x4 v0, v1;
          v0.x = (vv[0] & 0xffffu) | (vv[1] << 16); v0.y = (vv[2] & 0xffffu) | (vv[3] << 16); v0.z = (vv[4] & 0xffffu) | (vv[5] << 16); v0.w = (vv[6] & 0xffffu) | (vv[7] << 16);
          v1.x = (vv[0] >> 16) | (vv[1] & 0xffff0000u); v1.y = (vv[2] >> 16) | (vv[3] & 0xffff0000u); v1.z = (vv[4] >> 16) | (vv[5] & 0xffff0000u); v1.w = (vv[6] >> 16) | (vv[7] & 0xffff0000u);
          *(LAS u32x4*)(VT + (2 * kp) * 72 + t0) = v0; *(LAS u32x4*)(VT + (2 * kp + 1) * 72 + t0) = v1; }
        if (wid == 0) { f32x2 dv; dv.x = __expf(blast.x); dv.y = __expf(blast.y); *(LAS f32x2*)(dec + 2 * kp) = dv; }
        if (n + 1 < 8) {
            const size_t r1 = r0 + 64;
#pragma unroll
            for (int j = 0; j < 8; ++j) { const size_t row = r1 + t0 + j; lf[j] = *(const f32x2*)(LOGF + row * 1024 + h * 128 + 2 * kp); vv[j] = *(const unsigned*)(P + row * PLD + 1024 + h * 128 + 2 * kp); if (FULL) qv[j] = *(const unsigned*)(P + row * PLD + h * 128 + 2 * kp); }
        }
        LBAR();
        f32x4 o[4];
        if (FULL) {
#pragma unroll
            for (int q = 0; q < 2; ++q) { const int id = wid * 2 + q, t2 = id >> 2, st = id & 3;
                f32x4 acc = {0.f, 0.f, 0.f, 0.f};
                if (st <= t2) {
#pragma unroll
                    for (int ks = 0; ks < 4; ++ks) acc = MFMA16(ldfrag(Kd, 136, st * 16 + fr, ks * 32 + 8 * fq), ldfrag(Qd, 136, t2 * 16 + fr, ks * 32 + 8 * fq), acc);
                }
                const int t = t2 * 16 + fr, s0 = st * 16 + 4 * fq;
                u32x2 w; w.x = cvt_pk_bf16(s0 + 0 <= t ? acc[0] : 0.f, s0 + 1 <= t ? acc[1] : 0.f); w.y = cvt_pk_bf16(s0 + 2 <= t ? acc[2] : 0.f, s0 + 3 <= t ? acc[3] : 0.f);
                *(LAS u32x2*)(Pm + t * 72 + s0) = w; }
            LBAR();
            float ss = 0.f;
#pragma unroll
            for (int vt = 0; vt < 4; ++vt) { const int vrow = (vh * 4 + vt) * 16 + fr; f32x4 acc = {0.f, 0.f, 0.f, 0.f};
#pragma unroll
                for (int ks = 0; ks < 2; ++ks) acc = MFMA16(ldfrag(VT, 72, vrow, ks * 32 + 8 * fq), ldfrag(Pm, 72, tt * 16 + fr, ks * 32 + 8 * fq), acc);
#pragma unroll
                for (int ks = 0; ks < 4; ++ks) acc = MFMA16(ldfrag(ST, 136, vrow, ks * 32 + 8 * fq), ldfrag(Qb, 136, tt * 16 + fr, ks * 32 + 8 * fq), acc);
                o[vt] = acc; ss += (acc[0] * acc[0] + acc[1] * acc[1]) + (acc[2] * acc[2] + acc[3] * acc[3]); }
            ss += __shfl_xor(ss, 16); ss += __shfl_xor(ss, 32);
            if (fq == 0) rsq[vh * 64 + tt * 16 + fr] = ss;
        }
#pragma unroll
        for (int kt = 0; kt < 8; ++kt) { const f32x4 d = *(const LAS f32x4*)(dec + kt * 16 + 4 * fq); f32x4 acc = sacc[kt] * d;
#pragma unroll
            for (int ks = 0; ks < 2; ++ks) acc = MFMA16(ldfrag(KlT, 72, kt * 16 + fr, ks * 32 + 8 * fq), ldfrag(VT, 72, wid * 16 + fr, ks * 32 + 8 * fq), acc);
            sacc[kt] = acc; }
        LBAR();
        if (FULL) {
            { const int t = tt * 16 + fr; const float rstd = 1.0f / sqrtf((rsq[t] + rsq[64 + t]) * (1.0f / 128.0f) + EPS); const size_t row = r0 + t;
#pragma unroll
              for (int vt = 0; vt < 4; ++vt) { const int v0 = h * 128 + (vh * 4 + vt) * 16 + 4 * fq; const u32x2 g = gg[vt];
                  u32x2 w; w.x = cvt_pk_bf16(o[vt][0] * rstd * gn[vt].x * bflo(g.x), o[vt][1] * rstd * gn[vt].y * bfhi(g.x)); w.y = cvt_pk_bf16(o[vt][2] * rstd * gn[vt].z * bflo(g.y), o[vt][3] * rstd * gn[vt].w * bfhi(g.y));
                  *(u32x2*)(OA + row * 1024 + v0) = w; } }
            if (n + 1 < 8) {
#pragma unroll
                for (int kt = 0; kt < 8; ++kt) { u32x2 w; w.x = cvt_pk_bf16(sacc[kt][0], sacc[kt][1]); w.y = cvt_pk_bf16(sacc[kt][2], sacc[kt][3]);
                    *(LAS u32x2*)(ST + (wid * 16 + fr) * 136 + kt * 16 + 4 * fq) = w; }
            }
        }
    }
    if (!FULL) {
#pragma unroll
        for (int kt = 0; kt < 8; ++kt) *(f32x4*)(SSEG + ((size_t)unit * 8 + kt) * 2048 + tid * 4) = sacc[kt];
        if (wid == 0) { f32x2 dv; dv.x = __expf(dsum.x); dv.y = __expf(dsum.y); *(f32x2*)(DSEG + (size_t)unit * 128 + 2 * kp) = dv; }
    }
    LBAR();
}
__device__ __forceinline__ void hgrn_state(int b, int h, int sg, const bf16_t* P, const float* LOGF, float* SSEG, float* DSEG, LAS unsigned char* lds, int tid) {
    const int lane = tid & 63, wid = __builtin_amdgcn_readfirstlane(tid >> 6), fr = lane & 15, fq = lane >> 4;
    LAS bf16_t* KlT = (LAS bf16_t*)lds;
    LAS bf16_t* VT = KlT + 128 * 136;
    LAS float* segtot = (LAS float*)(VT + 128 * 136);
    const int unit = (b * 8 + h) * 8 + sg, kp = lane, t0 = wid * 16;
    f32x4 sacc[8];
#pragma unroll
    for (int kt = 0; kt < 8; ++kt) sacc[kt] = (f32x4){0.f, 0.f, 0.f, 0.f};
    f32x2 carry = {0.f, 0.f};
    f32x2 lf[16]; unsigned vv[16];
    const size_t rseg = (size_t)b * SEQ + (size_t)sg * 512;
#pragma unroll
    for (int j = 0; j < 16; ++j) { const size_t row = rseg + 384 + t0 + j; lf[j] = *(const f32x2*)(LOGF + row * 1024 + h * 128 + 2 * kp); vv[j] = *(const unsigned*)(P + row * PLD + 1024 + h * 128 + 2 * kp); }
    for (int sb = 3; sb >= 0; --sb) {
        f32x2 suf[16];
        { f32x2 a = {0.f, 0.f};
#pragma unroll
          for (int j = 15; j >= 0; --j) { suf[j] = a; a += lf[j]; }
          *(LAS f32x2*)(segtot + wid * 128 + 2 * kp) = a; }
        LBAR();
        f32x2 after = carry, sub = {0.f, 0.f};
#pragma unroll
        for (int w = 0; w < 8; ++w) { const f32x2 tv = *(const LAS f32x2*)(segtot + w * 128 + 2 * kp); if (w > wid) after += tv; sub += tv; }
        carry += sub;
        float kl0[16], kl1[16];
#pragma unroll
        for (int j = 0; j < 16; ++j) { const f32x2 e = suf[j] + after; kl0[j] = (1.0f - __expf(lf[j].x)) * __expf(e.x); kl1[j] = (1.0f - __expf(lf[j].y)) * __expf(e.y); }
#pragma unroll
        for (int q = 0; q < 2; ++q) { u32x4 w0, w1, v0, v1;
            w0.x = cvt_pk_bf16(kl0[8 * q + 0], kl0[8 * q + 1]); w0.y = cvt_pk_bf16(kl0[8 * q + 2], kl0[8 * q + 3]); w0.z = cvt_pk_bf16(kl0[8 * q + 4], kl0[8 * q + 5]); w0.w = cvt_pk_bf16(kl0[8 * q + 6], kl0[8 * q + 7]);
            w1.x = cvt_pk_bf16(kl1[8 * q + 0], kl1[8 * q + 1]); w1.y = cvt_pk_bf16(kl1[8 * q + 2], kl1[8 * q + 3]); w1.z = cvt_pk_bf16(kl1[8 * q + 4], kl1[8 * q + 5]); w1.w = cvt_pk_bf16(kl1[8 * q + 6], kl1[8 * q + 7]);
            *(LAS u32x4*)(KlT + (2 * kp) * 136 + t0 + 8 * q) = w0; *(LAS u32x4*)(KlT + (2 * kp + 1) * 136 + t0 + 8 * q) = w1;
            v0.x = (vv[8 * q + 0] & 0xffffu) | (vv[8 * q + 1] << 16); v0.y = (vv[8 * q + 2] & 0xffffu) | (vv[8 * q + 3] << 16); v0.z = (vv[8 * q + 4] & 0xffffu) | (vv[8 * q + 5] << 16); v0.w = (vv[8 * q + 6] & 0xffffu) | (vv[8 * q + 7] << 16);
            v1.x = (vv[8 * q + 0] >> 16) | (vv[8 * q + 1] & 0xffff0000u); v1.y = (vv[8 * q + 2] >> 16) | (vv[8 * q + 3] & 0xffff0000u); v1.z = (vv[8 * q + 4] >> 16) | (vv[8 * q + 5] & 0xffff0000u); v1.w = (vv[8 * q + 6] >> 16) | (vv[8 * q + 7] & 0xffff0000u);
            *(LAS u32x4*)(VT + (2 * kp) * 136 + t0 + 8 * q) = v0; *(LAS u32x4*)(VT + (2 * kp + 1) * 136 + t0 + 8 * q) = v1; }
        if (sb > 0) {
#pragma unroll
            for (int j = 0; j < 16; ++j) { const size_t row = rseg + (size_t)(sb - 1) * 128 + t0 + j; lf[j] = *(const f32x2*)(LOGF + row * 1024 + h * 128 + 2 * kp); vv[j] = *(const unsigned*)(P + row * PLD + 1024 + h * 128 + 2 * kp); }
        }
        LBAR();
        bf16x8 vf[4];
#pragma unroll
        for (int ks = 0; ks < 4; ++ks) vf[ks] = ldfrag(VT, 136, wid * 16 + fr, ks * 32 + 8 * fq);
#pragma unroll
        for (int kt = 0; kt < 8; ++kt) { f32x4 acc = sacc[kt];
#pragma unroll
            for (int ks = 0; ks < 4; ++ks) acc = MFMA16(ldfrag(KlT, 136, kt * 16 + fr, ks * 32 + 8 * fq), vf[ks], acc);
            sacc[kt] = acc; }
        LBAR();
    }
#pragma unroll
    for (int kt = 0; kt < 8; ++kt) *(f32x4*)(SSEG + ((size_t)unit * 8 + kt) * 2048 + tid * 4) = sacc[kt];
    if (wid == 0) { f32x2 dv; dv.x = __expf(carry.x); dv.y = __expf(carry.y); *(f32x2*)(DSEG + (size_t)unit * 128 + 2 * kp) = dv; }
}
struct SwaRaw { u32x4 k[4], v[4], q[2]; };
__device__ __forceinline__ void swa_load(SwaRaw& R, int b, int kvh, int nb, const bf16_t* P, int tid) {
    const size_t rq0 = (size_t)b * SEQ + (size_t)nb * 128; const int ch = tid & 7;
#pragma unroll
    for (int p = 0; p < 4; ++p) { const int ki = (tid >> 3) + 64 * p; const bool valid = (nb > 0) || (ki >= 128);
        R.k[p] = (u32x4){0u, 0u, 0u, 0u}; R.v[p] = (u32x4){0u, 0u, 0u, 0u};
        if (valid) { const size_t row = rq0 - 128 + ki; R.k[p] = *(const u32x4*)(P + row * PLD + 4096 + kvh * 64 + ch * 8); R.v[p] = *(const u32x4*)(P + row * PLD + 4352 + kvh * 64 + ch * 8); } }
#pragma unroll
    for (int p = 0; p < 2; ++p) R.q[p] = *(const u32x4*)(P + (rq0 + (tid >> 3) + 64 * p) * PLD + 3072 + (kvh * 4) * 64 + ch * 8);
}
__device__ __forceinline__ void swa_compute(SwaRaw& R, int b, int kvh, int nb, const bf16_t* P, const float* __restrict__ qg, const float* __restrict__ kg, const float* __restrict__ sinks, bf16_t* OB, LAS unsigned char* lds, int tid) {
    const int lane = tid & 63, wid = __builtin_amdgcn_readfirstlane(tid >> 6), fr = lane & 15, fq = lane >> 4;
    LAS bf16_t* Qs = (LAS bf16_t*)lds;
    LAS bf16_t* Ks = Qs + 128 * 72;
    LAS bf16_t* Vr = Ks + 256 * 72;
    LAS bf16_t* Pw = Vr + 256 * 72 + wid * (16 * 168);
    const size_t rq0 = (size_t)b * SEQ + (size_t)nb * 128;
    const int ch = tid & 7;
    {
        const f32x4 g0 = *(const f32x4*)(kg + ch * 8), g1 = *(const f32x4*)(kg + ch * 8 + 4);
#pragma unroll
        for (int p = 0; p < 4; ++p) { const int ki = (tid >> 3) + 64 * p; const u32x4 raw = R.k[p], rv = R.v[p];
            float x[8] = {bflo(raw.x), bfhi(raw.x), bflo(raw.y), bfhi(raw.y), bflo(raw.z), bfhi(raw.z), bflo(raw.w), bfhi(raw.w)};
            float ss = 0.f;
#pragma unroll
            for (int e = 0; e < 8; ++e) ss += x[e] * x[e];
            ss += __shfl_xor(ss, 1); ss += __shfl_xor(ss, 2); ss += __shfl_xor(ss, 4);
            const float rs = 1.0f / sqrtf(ss * (1.0f / 64.0f) + EPS);
            u32x4 w; w.x = cvt_pk_bf16(x[0] * rs * g0.x, x[1] * rs * g0.y); w.y = cvt_pk_bf16(x[2] * rs * g0.z, x[3] * rs * g0.w); w.z = cvt_pk_bf16(x[4] * rs * g1.x, x[5] * rs * g1.y); w.w = cvt_pk_bf16(x[6] * rs * g1.z, x[7] * rs * g1.w);
            *(LAS u32x4*)(Ks + ki * 72 + ch * 8) = w;
            *(LAS u32x4*)(Vr + ki * 72 + ch * 8) = rv; }
    }
    const f32x4 qg0 = *(const f32x4*)(qg + ch * 8), qg1 = *(const f32x4*)(qg + ch * 8 + 4);
    const int kt0 = wid > 0 ? wid - 1 : 0;
    for (int g = 0; g < 4; ++g) {
        const int hq = kvh * 4 + g;
#pragma unroll
        for (int p = 0; p < 2; ++p) { const int row = (tid >> 3) + 64 * p; const u32x4 raw = R.q[p];
            float x[8] = {bflo(raw.x), bfhi(raw.x), bflo(raw.y), bfhi(raw.y), bflo(raw.z), bfhi(raw.z), bflo(raw.w), bfhi(raw.w)};
            float ss = 0.f;
#pragma unroll
            for (int e = 0; e < 8; ++e) ss += x[e] * x[e];
            ss += __shfl_xor(ss, 1); ss += __shfl_xor(ss, 2); ss += __shfl_xor(ss, 4);
            const float rs = 0.125f / sqrtf(ss * (1.0f / 64.0f) + EPS);
            u32x4 w; w.x = cvt_pk_bf16(x[0] * rs * qg0.x, x[1] * rs * qg0.y); w.y = cvt_pk_bf16(x[2] * rs * qg0.z, x[3] * rs * qg0.w); w.z = cvt_pk_bf16(x[4] * rs * qg1.x, x[5] * rs * qg1.y); w.w = cvt_pk_bf16(x[6] * rs * qg1.z, x[7] * rs * qg1.w);
            *(LAS u32x4*)(Qs + row * 72 + ch * 8) = w; }
        if (g < 3) {
#pragma unroll
            for (int p = 0; p < 2; ++p) R.q[p] = *(const u32x4*)(P + (rq0 + (tid >> 3) + 64 * p) * PLD + 3072 + (hq + 1) * 64 + ch * 8);
        }
        LBAR();
        f32x4 s[10];
#pragma unroll
        for (int j = 0; j < 10; ++j) { f32x4 acc = {0.f, 0.f, 0.f, 0.f};
#pragma unroll
            for (int ks = 0; ks < 2; ++ks) acc = MFMA16(ldfrag(Ks, 72, (kt0 + j) * 16 + fr, ks * 32 + 8 * fq), ldfrag(Qs, 72, wid * 16 + fr, ks * 32 + 8 * fq), acc);
            s[j] = acc; }
        const int qi = wid * 16 + fr; const float sink = sinks[hq]; float m = sink;
#pragma unroll
        for (int j = 0; j < 10; ++j)
#pragma unroll
            for (int r = 0; r < 4; ++r) { const int ki = (kt0 + j) * 16 + 4 * fq + r; const bool valid = (ki > qi) && (ki <= qi + 128) && ((nb > 0) || (ki >= 128));
                s[j][r] = valid ? s[j][r] : -INFINITY; m = fmaxf(m, s[j][r]); }
        m = fmaxf(m, __shfl_xor(m, 16)); m = fmaxf(m, __shfl_xor(m, 32));
        float sum = 0.f;
#pragma unroll
        for (int j = 0; j < 10; ++j) {
#pragma unroll
            for (int r = 0; r < 4; ++r) { s[j][r] = __expf(s[j][r] - m); sum += s[j][r]; }
            u32x2 w; w.x = cvt_pk_bf16(s[j][0], s[j][1]); w.y = cvt_pk_bf16(s[j][2], s[j][3]);
            *(LAS u32x2*)(Pw + fr * 168 + j * 16 + 4 * fq) = w; }
        sum += __shfl_xor(sum, 16); sum += __shfl_xor(sum, 32);
        const float inv = 1.0f / (sum + __expf(sink - m));
        asm volatile("s_waitcnt lgkmcnt(0)" ::: "memory"); __builtin_amdgcn_wave_barrier();
#pragma unroll
        for (int dt = 0; dt < 4; ++dt) { f32x4 acc = {0.f, 0.f, 0.f, 0.f};
#pragma unroll
            for (int ks = 0; ks < 5; ++ks) { const LAS bf16_t* vp = Vr + (kt0 * 16 + ks * 32 + 8 * fq + (fr >> 2)) * 72 + dt * 16 + 4 * (fr & 3);
                const v4i16_t lo = __builtin_amdgcn_ds_read_tr16_b64_v4i16((LAS v4i16_t*)vp), hi = __builtin_amdgcn_ds_read_tr16_b64_v4i16((LAS v4i16_t*)(vp + 4 * 72));
                const bf16x8 vf = {lo[0], lo[1], lo[2], lo[3], hi[0], hi[1], hi[2], hi[3]};
                acc = MFMA16(vf, ldfrag(Pw, 168, fr, ks * 32 + 8 * fq), acc); }
            u32x2 w; w.x = cvt_pk_bf16(acc[0] * inv, acc[1] * inv); w.y = cvt_pk_bf16(acc[2] * inv, acc[3] * inv);
            *(u32x2*)(OB + (rq0 + qi) * 1024 + hq * 64 + dt * 16 + 4 * fq) = w; }
        LBAR();
    }
}

struct Args { const float* in[17]; float* out; unsigned char* ws; };
__global__ void __launch_bounds__(NTHR, 2) fwd_megakernel(Args a) {
    extern __shared__ __attribute__((aligned(16))) unsigned char lds_raw[];
    cg::grid_group grid = cg::this_grid();
    LAS unsigned char* lds = (LAS unsigned char*)lds_raw;
    const int tid = threadIdx.x, lane = tid & 63, wave = __builtin_amdgcn_readfirstlane(tid >> 6);
    const int G = gridDim.x, blk = blockIdx.x;
    const int vcu = (G % 8 == 0) ? (blk % 8) * (G / 8) + blk / 8 : blk;
    const int gw = vcu * 8 + wave, NGW = G * 8;
    const float *x = a.in[0], *cvec = a.in[1], *w_ada = a.in[2], *b_ada = a.in[3], *g1 = a.in[4], *w_in = a.in[5], *lbl = a.in[6], *ogain = a.in[7], *qg = a.in[8], *kg = a.in[9], *sinks = a.in[10],
                *w_a = a.in[11], *w_b = a.in[12], *w_o = a.in[13], *g2 = a.in[14], *w1 = a.in[15], *w2 = a.in[16];
    unsigned char* ws = a.ws;
    float* mod = (float*)(ws + WS_MOD);
    bf16_t *WinT = (bf16_t*)(ws + WS_WIN), *WabT = (bf16_t*)(ws + WS_WAB), *WoT = (bf16_t*)(ws + WS_WO), *W1T = (bf16_t*)(ws + WS_W1), *W2T = (bf16_t*)(ws + WS_W2);
    bf16_t *H = (bf16_t*)(ws + WS_H), *P = (bf16_t*)(ws + WS_P), *U = (bf16_t*)(ws + WS_P);
    float* out = a.out;
    float* LOGF = out;
    bf16_t* OAB = (bf16_t*)(out + (size_t)M * 1024);
    float* SSEG = (float*)(ws + WS_SSEG); float* DSEG = (float*)(ws + WS_DSEG);
    bf16_t* H2 = (bf16_t*)(ws + WS_H2); float* cb = (float*)(ws + WS_CB); float* part = (float*)(ws + WS_PART);
    volatile LAS unsigned* MISC = (volatile LAS unsigned*)(lds + MISC_OFF);
    if (tid < 16) MISC[tid] = 0u;
    __syncthreads();
    XcdBarrier bar = xcd_barrier_post((unsigned*)(ws + WS_BAR), MISC + 8);
#define GRID_SYNC() xcd_barrier(bar)
    if (a.ws == nullptr) grid.sync();

    for (int it = blk; it < NMOD / 48; it += G) gemv_item(cvec, w_ada, b_ada, mod, lds, it, tid);
    LAS float* scr = (LAS float*)(lds + wave * 16640);
    constexpr int I_IN = (DM / 64) * (INW / 64), I_A = (1024 / 64) * (DM / 64), I_O = (DM / 64) * (DM / 64), I_1 = (DM / 64) * (HID / 64), I_2 = (HID / 64) * (DM / 64);
    constexpr int NP0 = I_IN + 2 * I_A + I_O, NITEMS = NP0 + I_1 + I_2;
    {
#define TR_DECODE(it_, d_) do { int r_ = (it_); \
            if (r_ < I_IN) { d_ = TrDesc{w_in, WinT, DM, INW, 0, r_}; break; } r_ -= I_IN; \
            if (r_ < I_A) { d_ = TrDesc{w_b, WabT, 1024, DM, 0, r_}; break; } r_ -= I_A; \
            if (r_ < I_A) { d_ = TrDesc{w_a, WabT, 1024, DM, DM, r_}; break; } r_ -= I_A; \
            if (r_ < I_O) { d_ = TrDesc{w_o, WoT, DM, DM, 0, r_}; break; } r_ -= I_O; \
            if (r_ < I_1) { d_ = TrDesc{w1, W1T, DM, HID, 0, r_}; break; } r_ -= I_1; \
            d_ = TrDesc{w2, W2T, HID, DM, 0, r_}; } while (0)
#define TR_RUN(first_, stride_, hi_) do { int it = (first_); \
        if (it < (hi_)) { f32x4 va[16], vb[16]; TrDesc da, db; TR_DECODE(it, da); tr_load(da, lane, va); \
            for (;;) { const int it2 = it + (stride_); const bool h2 = it2 < (hi_); \
                if (h2) { TR_DECODE(it2, db); tr_load(db, lane, vb); } \
                tr_store(da, lane, va, scr); if (!h2) break; \
                const int it3 = it2 + (stride_); const bool h3 = it3 < (hi_); \
                if (h3) { TR_DECODE(it3, da); tr_load(da, lane, va); } \
                tr_store(db, lane, vb, scr); if (!h3) break; it = it3; } } } while (0)
        TR_RUN(gw, NGW, NP0);
    }
    GRID_SYNC();
    norm_phase(x, g1, mod, 0, DM, H, gw, NGW, lane);
    GRID_SYNC();
    {
        pg8::Gemm g{H, WinT, M, INW, DM}; pg8::InOrder S; S.base.init(M, INW, G, blk);
        pg8::EpiIn E{P, LOGF, lbl};
        pg8::gemm_phase<pg8::EpiIn, pg8::InOrder, true, true>(lds, g, S, E);
    }
    {
        constexpr int nwg = (M / 256) * (INW / 256);
        const int maxu = (nwg + G - 1) / G, first_idle = nwg - (maxu - 1) * G, n_idle = first_idle < G ? G - first_idle : 0;
        if (n_idle > 0) { if (blk >= first_idle) TR_RUN(NP0 + (blk - first_idle) * 8 + wave, n_idle * 8, NITEMS); }
        else TR_RUN(NP0 + gw, NGW, NITEMS);
    }
    GRID_SYNC();
    for (int u = blk; u < 256; u += G) { SwaRaw R; swa_load(R, u >> 7, (u >> 5) & 3, u & 31, P, tid);
        hgrn_state(u >> 6, (u >> 3) & 7, u & 7, P, LOGF, SSEG, DSEG, lds, tid);
        swa_compute(R, u >> 7, (u >> 5) & 3, u & 31, P, qg, kg, sinks, OAB, lds, tid); }
    if (G == 256) bias_phase(W1T, mod, cb, gw, NGW, lane);
    GRID_SYNC();
    for (int u = blk; u < 256; u += G) { const int us = 256 + u;
        hgrn_seg<true>(u >> 6, (u >> 3) & 7, u & 7, P, LOGF, ogain, OAB + (size_t)M * 1024, SSEG, DSEG, lds, tid);
        SwaRaw R; swa_load(R, us >> 7, (us >> 5) & 3, us & 31, P, tid);
        swa_compute(R, us >> 7, (us >> 5) & 3, us & 31, P, qg, kg, sinks, OAB, lds, tid); }
    GRID_SYNC();
    {
        pg8::Gemm g{OAB, WabT, 2 * M, 2 * DM, 1024}; pg8::PairOrder S; S.base.init(M, DM, G, blk);
        pg8::EpiMerge E{P, H};
        pg8::gemm_phase<pg8::EpiMerge, pg8::PairOrder, true, true>(lds, g, S, E);
    }
    GRID_SYNC();
    if (G == 256) {
    {
        pg8::Gemm g{H, WoT, M, DM, DM}; pg8::StaticOrderW<4> S; S.init(M, DM, G, blk);
        pg8::EpiRes3 E{x, out, mod, g2, H2, part};
        pg8::gemm_phase<pg8::EpiRes3, pg8::StaticOrderW<4>, true, true>(lds, g, S, E);
    }
    GRID_SYNC();
    {
        pg8::Gemm g{H2, W1T, M, HID, DM}; pg8::StaticOrderW<4> S; S.init(M, HID, G, blk);
        pg8::Unit u0; S.next(0, u0);
        LAS float* rstd = (LAS float*)(lds + 131072 + 1024);
        { const int row = ((u0.pm & ~4) | ((tid >> 8) << 2)) * 256 + (tid & 255); float sacc = 0.f;
#pragma unroll 8
          for (int j = 0; j < 32; ++j) sacc += part[(size_t)j * 16384 + row];
          rstd[tid] = 1.0f / sqrtf(sacc * (1.0f / DM) + EPS); }
        __syncthreads();
        pg8::EpiUp2 E{U, HID, rstd, cb};
        pg8::gemm_phase<pg8::EpiUp2, pg8::StaticOrderW<4>, true, true>(lds, g, S, E);
    }
    GRID_SYNC();
    } else {
    {
        pg8::Gemm g{H, WoT, M, DM, DM}; pg8::StaticOrder S; S.init(M, DM, G, blk);
        pg8::EpiRes E{x, out, mod + 2 * DM};
        pg8::gemm_phase<pg8::EpiRes, pg8::StaticOrder, true, true>(lds, g, S, E);
    }
    GRID_SYNC();
    norm_phase(out, g2, mod, 3 * DM, 4 * DM, H, gw, NGW, lane);
    GRID_SYNC();
    {
        pg8::Gemm g{H, W1T, M, HID, DM}; pg8::StaticOrder S; S.init(M, HID, G, blk);
        pg8::EpiRelu2 E{U, HID};
        pg8::gemm_phase<pg8::EpiRelu2, pg8::StaticOrder, true, true>(lds, g, S, E);
    }
    GRID_SYNC();
    }
    {
        pg8::Gemm g{U, W2T, M, DM, HID}; pg8::StaticOrderW<4> S; S.init(M, DM, G, blk);
        pg8::EpiRes E{out, out, mod + 5 * DM};
        pg8::gemm_phase<pg8::EpiRes, pg8::StaticOrderW<4>, true, true>(lds, g, S, E);
    }
}

extern "C" void kernel_launch(void* const* d_in, const int* in_sizes, int n_in, void* d_out, int out_size, void* d_ws, size_t ws_size, hipStream_t stream) {
    static int grid_blocks = 0;
    if (grid_blocks == 0) {
        if (n_in != 17 || out_size != M * DM || ws_size < WS_END) { fprintf(stderr, "kernel_launch: unexpected shapes (n_in %d out %d ws %zu)\n", n_in, out_size, ws_size); grid_blocks = -1; return; }
        int dev = 0, cus = 0, per_cu = 0;
        (void)hipGetDevice(&dev);
        (void)hipDeviceGetAttribute(&cus, hipDeviceAttributeMultiprocessorCount, dev);
        if (hipFuncSetAttribute((const void*)fwd_megakernel, hipFuncAttributeMaxDynamicSharedMemorySize, LDS_BYTES) != hipSuccess) { fprintf(stderr, "kernel_launch: hipFuncSetAttribute failed\n"); grid_blocks = -1; return; }
        if (hipOccupancyMaxActiveBlocksPerMultiprocessor(&per_cu, (const void*)fwd_megakernel, NTHR, LDS_BYTES) != hipSuccess || per_cu < 1) { fprintf(stderr, "kernel_launch: occupancy query says %d\n", per_cu); (void)hipGetLastError(); grid_blocks = -1; return; }
        grid_blocks = cus;
        fprintf(stderr, "kernel_launch: %d CUs, %d blocks/CU by occupancy, launching %d blocks\n", cus, per_cu, grid_blocks);
    }
    if (grid_blocks < 0) return;
    if (hipMemsetAsync((char*)d_ws + WS_BAR, 0, ZERO_BYTES, stream) != hipSuccess) { fprintf(stderr, "kernel_launch: memset failed\n"); return; }
    Args a{};
    for (int i = 0; i < 17; ++i) a.in[i] = (const float*)d_in[i];
    a.out = (float*)d_out; a.ws = (unsigned char*)d_ws;
    void* args[] = {&a};
    hipError_t e = hipLaunchCooperativeKernel((const void*)fwd_megakernel, dim3(grid_blocks), dim3(NTHR), args, LDS_BYTES, stream);
    if (e != hipSuccess) fprintf(stderr, "cooperative launch failed: %s (grid %d)\n", hipGetErrorString(e), grid_blocks);
}
```
